# Optimizing an MI355X kernel written in HIP

```python
import jax, jax.numpy as jnp
from jax import lax
import numpy as np

D_MODEL = 1024
BATCH = 16
SEQ = 4096
DEPTH = 4

GRID_W = 64
CTX_LEN = 256
N_EVEN = (DEPTH + 1) // 2
N_ODD = DEPTH // 2
N_SUB = 3
D_FF = 2816
HEAD_DIM = 64
NA_HEADS = 12
NA_WIN_ROWS = 8
NA_WIN_COLS = 16
NA_QCOL_BLOCK = 16
NA_KCOL_BLOCK = 32
NA_W = NA_HEADS * HEAD_DIM
FNET_GROUPS = 4
FNET_GROUP_DIM = 64
FNET_W = FNET_GROUPS * FNET_GROUP_DIM
IN_EVEN = 3 * NA_W + FNET_W
MIX_EVEN = NA_W + FNET_W
GQA_Q_HEADS = 8
GQA_KV_HEADS = 2
GQA_Q_W = GQA_Q_HEADS * HEAD_DIM
GQA_KV_W = GQA_KV_HEADS * HEAD_DIM
SGU_GROUPS = 4
SGU_CHUNK = 128
SGU_GROUP_DIM = 128
SGU_W = SGU_GROUPS * SGU_GROUP_DIM
IN_ODD = GQA_Q_W + 2 * GQA_KV_W + 2 * SGU_W
MIX_ODD = GQA_Q_W + SGU_W
Q_BLOCK = 128
ROPE_THETA = 10000.0
EPS = 1e-6
NEG_INF = -1e30

kernel_name = "hybrid_natten_fnet_gqa_sgu_macaron_dit"


def rms_norm(x, g):
    x32 = x.astype(jnp.float32)
    y = x32 * lax.rsqrt(jnp.mean(x32 * x32, axis=-1, keepdims=True) + EPS)
    return (y * g.astype(jnp.float32)).astype(x.dtype)


def modulate(h, shift, scale):
    return h * (1 + scale) + shift


def swiglu(h, w_gu, w_down):
    gate, up = jnp.split(h @ w_gu, 2, axis=-1)
    return (jax.nn.silu(gate) * up) @ w_down


def macaron_ffn(x, g, shift, scale, gate, w_gu, w_down):
    h = modulate(rms_norm(x, g), shift, scale)
    return x + 0.5 * gate * swiglu(h, w_gu, w_down)


def heads(z, n):
    return z.reshape(z.shape[:-1] + (n, HEAD_DIM))


def axial_rope_tables(n_tokens):
    t = jnp.arange(n_tokens, dtype=jnp.int32)
    n_freq = HEAD_DIM // 4
    inv_freq = ROPE_THETA ** (-jnp.arange(n_freq, dtype=jnp.float32) / n_freq)
    row = (t // GRID_W).astype(jnp.float32)[:, None] * inv_freq
    col = (t % GRID_W).astype(jnp.float32)[:, None] * inv_freq
    ang = jnp.concatenate([row, col], axis=-1)
    return jnp.cos(ang), jnp.sin(ang)


def apply_rope(x, cos, sin):
    xf = x.astype(jnp.float32).reshape(x.shape[:-1] + (HEAD_DIM // 2, 2))
    x0, x1 = xf[..., 0], xf[..., 1]
    c = cos[None, :, None, :]
    s = sin[None, :, None, :]
    out = jnp.stack([x0 * c - x1 * s, x0 * s + x1 * c], axis=-1)
    return out.reshape(x.shape).astype(x.dtype)


def gqa_attend(q, k, v):
    b, tq, hq, dh = q.shape
    hkv = k.shape[2]
    qg = q.reshape(b, tq, hkv, hq // hkv, dh)
    s = jnp.einsum('bqkgd,btkd->bkgqt', qg, k).astype(jnp.float32) * (dh ** -0.5)
    p = jax.nn.softmax(s, axis=-1).astype(v.dtype)
    o = jnp.einsum('bkgqt,btkd->bqkgd', p, v)
    return o.reshape(b, tq, hq * dh)


def blocked_gqa_attend(q, k, v):
    b, s, hq, dh = q.shape
    nb = s // Q_BLOCK
    qb = q.reshape(b, nb, Q_BLOCK, hq, dh).transpose(1, 0, 2, 3, 4)
    out = lax.map(lambda qi: gqa_attend(qi, k, v), qb)
    return out.transpose(1, 0, 2, 3).reshape(b, s, hq * dh)


def neighbourhood_attend(q, k, v, k_ctx, v_ctx, rpb):
    b, s, h, dh = q.shape
    rows = s // GRID_W
    kr = min(NA_WIN_ROWS, rows)
    n_cb = GRID_W // NA_QCOL_BLOCK
    qcol = np.arange(GRID_W).reshape(n_cb, NA_QCOL_BLOCK)
    col_start = np.clip(qcol - NA_WIN_COLS // 2, 0, GRID_W - NA_WIN_COLS)
    kcol0 = np.clip(np.arange(n_cb) * NA_QCOL_BLOCK - NA_WIN_COLS // 2, 0, GRID_W - NA_KCOL_BLOCK)
    kcol = kcol0[:, None] + np.arange(NA_KCOL_BLOCK)
    col_ok = ((kcol[:, None, :] >= col_start[:, :, None]) &
              (kcol[:, None, :] < col_start[:, :, None] + NA_WIN_COLS))
    dcol_idx = np.clip(kcol[:, None, :] - qcol[:, :, None] + NA_WIN_COLS - 1, 0, 2 * NA_WIN_COLS - 2)
    row_start = np.clip(np.arange(rows) - kr // 2, 0, rows - kr).astype(np.int32)
    mask = jnp.asarray(col_ok[:, :, None, :])
    bias_col = rpb[:, :, dcol_idx]
    kg = k.reshape(b, rows, GRID_W, h, dh)
    vg = v.reshape(b, rows, GRID_W, h, dh)
    qg = q.reshape(b, rows, n_cb, NA_QCOL_BLOCK, h, dh).transpose(1, 0, 2, 3, 4, 5)
    scale = dh ** -0.5
    n_loc = kr * NA_KCOL_BLOCK

    def one_row(args):
        q_row, r, r0 = args
        k_nb = lax.dynamic_slice_in_dim(kg, r0, kr, axis=1)[:, :, kcol]
        v_nb = lax.dynamic_slice_in_dim(vg, r0, kr, axis=1)[:, :, kcol]
        s_loc = jnp.einsum('bjqhd,brjkhd->bhjqrk', q_row, k_nb).astype(jnp.float32) * scale
        drow_idx = r0 + jnp.arange(kr, dtype=jnp.int32) - r + NA_WIN_ROWS - 1
        bias = bias_col[:, drow_idx].transpose(0, 2, 3, 1, 4)
        s_loc = jnp.where(mask, s_loc + bias[None].astype(jnp.float32), NEG_INF)
        s_ctx = jnp.einsum('bjqhd,bthd->bhjqt', q_row, k_ctx).astype(jnp.float32) * scale
        sc = jnp.concatenate([s_loc.reshape(b, h, n_cb, NA_QCOL_BLOCK, n_loc), s_ctx], axis=-1)
        p = jax.nn.softmax(sc, axis=-1).astype(v.dtype)
        p_loc = p[..., :n_loc].reshape(b, h, n_cb, NA_QCOL_BLOCK, kr, NA_KCOL_BLOCK)
        o = (jnp.einsum('bhjqrk,brjkhd->bjqhd', p_loc, v_nb)
             + jnp.einsum('bhjqt,bthd->bjqhd', p[..., n_loc:], v_ctx))
        return o.reshape(b, GRID_W, h * dh)

    out = lax.map(one_row, (qg, jnp.arange(rows, dtype=jnp.int32), jnp.asarray(row_start)))
    return out.transpose(1, 0, 2, 3).reshape(b, s, h * dh)


def fourier_mix(f):
    b, t, _ = f.shape
    z = f.astype(jnp.float32).reshape(b, t, FNET_GROUPS, FNET_GROUP_DIM)
    y = jnp.fft.fft2(z, axes=(1, 3), norm="ortho").real
    return y.reshape(b, t, FNET_W).astype(f.dtype)


def spatial_gating(u, v, v_g, w_s, b_s):
    b, t, _ = u.shape
    u = jax.nn.gelu(u)
    v = rms_norm(jax.nn.gelu(v).reshape(b, t, SGU_GROUPS, SGU_GROUP_DIM),
                 v_g.reshape(SGU_GROUPS, SGU_GROUP_DIM))
    vc = v.reshape(b, t // SGU_CHUNK, SGU_CHUNK, SGU_GROUPS, SGU_GROUP_DIM)
    mixed = jnp.einsum('gij,bnjgc->bnigc', w_s, vc) + b_s.T[None, None, :, :, None]
    return u * mixed.reshape(b, t, SGU_W)


def mixer_ab(hl, hc, w_in, w_out, qk_g, rpb, with_ctx_out):
    shp_l = hl.shape[:2] + (NA_HEADS, HEAD_DIM)
    ql, kl, vl, fl = jnp.split(hl @ w_in, [NA_W, 2 * NA_W, 3 * NA_W], axis=-1)
    ql = rms_norm(ql.reshape(shp_l), qk_g[0])
    kl = rms_norm(kl.reshape(shp_l), qk_g[1])
    vl = vl.reshape(shp_l)
    if with_ctx_out:
        qc, kc, vc, fc = jnp.split(hc @ w_in, [NA_W, 2 * NA_W, 3 * NA_W], axis=-1)
    else:
        kc, vc = jnp.split(hc @ w_in[:, NA_W:3 * NA_W], 2, axis=-1)
    kc = rms_norm(heads(kc, NA_HEADS), qk_g[1])
    vc = heads(vc, NA_HEADS)
    att_l = neighbourhood_attend(ql, kl, vl, kc, vc, rpb)
    out_l = jnp.concatenate([att_l, fourier_mix(fl)], axis=-1) @ w_out
    if not with_ctx_out:
        return out_l, None
    qc = rms_norm(heads(qc, NA_HEADS), qk_g[0])
    att_c = gqa_attend(qc, kc, vc)
    out_c = jnp.concatenate([att_c, fourier_mix(fc)], axis=-1) @ w_out
    return out_l, out_c


def mixer_cd(hl, hc, w_in, w_out, qk_g, v_g, w_s, b_s, with_ctx_out):
    o_k = GQA_Q_W
    o_v = o_k + GQA_KV_W
    o_u = o_v + GQA_KV_W
    o_s = o_u + SGU_W
    ql, kl, val_l, ul, sl = jnp.split(hl @ w_in, [o_k, o_v, o_u, o_s], axis=-1)
    cos, sin = axial_rope_tables(hl.shape[1])
    ql = apply_rope(rms_norm(heads(ql, GQA_Q_HEADS), qk_g[0]), cos, sin)
    kl = apply_rope(rms_norm(heads(kl, GQA_KV_HEADS), qk_g[1]), cos, sin)
    val_l = heads(val_l, GQA_KV_HEADS)
    if with_ctx_out:
        qc, kc, val_c, uc, sc = jnp.split(hc @ w_in, [o_k, o_v, o_u, o_s], axis=-1)
    else:
        kc, val_c = jnp.split(hc @ w_in[:, o_k:o_u], 2, axis=-1)
    kc = rms_norm(heads(kc, GQA_KV_HEADS), qk_g[1])
    val_c = heads(val_c, GQA_KV_HEADS)
    att_l = blocked_gqa_attend(ql, jnp.concatenate([kl, kc], axis=1),
                               jnp.concatenate([val_l, val_c], axis=1))
    out_l = jnp.concatenate([att_l, spatial_gating(ul, sl, v_g, w_s, b_s)], axis=-1) @ w_out
    if not with_ctx_out:
        return out_l, None
    qc = rms_norm(heads(qc, GQA_Q_HEADS), qk_g[0])
    att_c = gqa_attend(qc, kc, val_c)
    out_c = jnp.concatenate([att_c, spatial_gating(uc, sc, v_g, w_s, b_s)], axis=-1) @ w_out
    return out_l, out_c


def setup_inputs(seed: int = 0) -> dict:
    key = jax.random.key(seed)
    ks = jax.random.split(key, 20)
    D = D_MODEL

    def nrm(k, shape, scale):
        return jax.random.normal(k, shape, jnp.float32) * scale

    return {
        "x": nrm(ks[0], (BATCH, SEQ, D), 1.0),
        "c": nrm(ks[1], (BATCH, D), 1.0),
        "ctx": nrm(ks[2], (BATCH, CTX_LEN, D), 1.0),
        "c_ctx": nrm(ks[3], (D,), 1.0),
        "norm_g": 1.0 + nrm(ks[4], (DEPTH, N_SUB, D), 0.02),
        "w_mod": nrm(ks[5], (DEPTH, D, N_SUB * 3 * D), 0.5 * D ** -0.5),
        "b_mod": nrm(ks[6], (DEPTH, N_SUB * 3 * D), 0.02),
        "ffn_w_gu": nrm(ks[7], (DEPTH, 2, D, 2 * D_FF), D ** -0.5),
        "ffn_w_down": nrm(ks[8], (DEPTH, 2, D_FF, D), D_FF ** -0.5),
        "w_in_ab": nrm(ks[9], (N_EVEN, D, IN_EVEN), D ** -0.5),
        "w_out_ab": nrm(ks[10], (N_EVEN, MIX_EVEN, D), MIX_EVEN ** -0.5),
        "qk_g_a": 1.0 + nrm(ks[11], (N_EVEN, 2, HEAD_DIM), 0.02),
        "rpb_a": nrm(ks[12], (N_EVEN, NA_HEADS, 2 * NA_WIN_ROWS - 1, 2 * NA_WIN_COLS - 1), 0.05),
        "w_in_cd": nrm(ks[13], (N_ODD, D, IN_ODD), D ** -0.5),
        "w_out_cd": nrm(ks[14], (N_ODD, MIX_ODD, D), MIX_ODD ** -0.5),
        "qk_g_d": 1.0 + nrm(ks[15], (N_ODD, 2, HEAD_DIM), 0.02),
        "v_g_c": 1.0 + nrm(ks[16], (N_ODD, SGU_W), 0.02),
        "w_s_c": nrm(ks[17], (N_ODD, SGU_GROUPS, SGU_CHUNK, SGU_CHUNK), SGU_CHUNK ** -0.5),
        "b_s_c": 1.0 + nrm(ks[18], (N_ODD, SGU_GROUPS, SGU_CHUNK), 0.02),
    }


def reference(x, c, ctx, c_ctx, norm_g, w_mod, b_mod, ffn_w_gu, ffn_w_down,
              w_in_ab, w_out_ab, qk_g_a, rpb_a, w_in_cd, w_out_cd, qk_g_d, v_g_c, w_s_c, b_s_c):
    b = x.shape[0]
    xl, xc = x, ctx
    silu_c = jax.nn.silu(c)
    silu_cc = jax.nn.silu(c_ctx)
    for layer in range(DEPTH):
        mod_l = (silu_c @ w_mod[layer] + b_mod[layer]).reshape(b, N_SUB, 3, 1, D_MODEL)
        mod_c = (silu_cc @ w_mod[layer] + b_mod[layer]).reshape(N_SUB, 3, D_MODEL)
        with_ctx_out = layer < DEPTH - 1
        xl = macaron_ffn(xl, norm_g[layer, 0], mod_l[:, 0, 0], mod_l[:, 0, 1], mod_l[:, 0, 2],
                         ffn_w_gu[layer, 0], ffn_w_down[layer, 0])
        xc = macaron_ffn(xc, norm_g[layer, 0], mod_c[0, 0], mod_c[0, 1], mod_c[0, 2],
                         ffn_w_gu[layer, 0], ffn_w_down[layer, 0])
        hl = modulate(rms_norm(xl, norm_g[layer, 1]), mod_l[:, 1, 0], mod_l[:, 1, 1])
        hc = modulate(rms_norm(xc, norm_g[layer, 1]), mod_c[1, 0], mod_c[1, 1])
        if layer % 2 == 0:
            i = layer // 2
            out_l, out_c = mixer_ab(hl, hc, w_in_ab[i], w_out_ab[i], qk_g_a[i], rpb_a[i], with_ctx_out)
        else:
            i = layer // 2
            out_l, out_c = mixer_cd(hl, hc, w_in_cd[i], w_out_cd[i], qk_g_d[i], v_g_c[i],
                                    w_s_c[i], b_s_c[i], with_ctx_out)
        xl = xl + mod_l[:, 1, 2] * out_l
        xl = macaron_ffn(xl, norm_g[layer, 2], mod_l[:, 2, 0], mod_l[:, 2, 1], mod_l[:, 2, 2],
                         ffn_w_gu[layer, 1], ffn_w_down[layer, 1])
        if with_ctx_out:
            xc = xc + mod_c[1, 2] * out_c
            xc = macaron_ffn(xc, norm_g[layer, 2], mod_c[2, 0], mod_c[2, 1], mod_c[2, 2],
                             ffn_w_gu[layer, 1], ffn_w_down[layer, 1])
    return xl
```

```cpp
#include <hip/hip_runtime.h>
#include <hip/hip_cooperative_groups.h>
#include <cstdio>
#include <cstdint>
namespace cg = cooperative_groups;

#define LAS __attribute__((address_space(3)))
#define DI __device__ __forceinline__
typedef unsigned short bf16_t;
typedef short bf16x8 __attribute__((ext_vector_type(8)));
typedef short s16x4 __attribute__((ext_vector_type(4)));
typedef float f32x4 __attribute__((ext_vector_type(4)));
typedef float f32x2 __attribute__((ext_vector_type(2)));
typedef unsigned u32x4 __attribute__((ext_vector_type(4)));
typedef unsigned u32x2 __attribute__((ext_vector_type(2)));
typedef __bf16 bf16x2_t __attribute__((ext_vector_type(2)));

#define LDS_WAIT() asm volatile("s_waitcnt lgkmcnt(0)" ::: "memory")
#define GLOBAL_PTR(T, p) ((T*)(__attribute__((address_space(1))) T*)(launder_u64((unsigned long long)(p))))
__device__ __forceinline__ unsigned long long launder_u64(unsigned long long v) { asm volatile("" : "+s"(v)); return v; }

constexpr int DM = 1024, NB = 16, SEQ = 4096, CTXL = 256, TL = NB * SEQ, TC = NB * CTXL, TT = TL + TC, DFF = 2816;
constexpr int MODW = 9216, NBI = 17;
constexpr int LDP_E = 1536, LDP_O = 1792;
constexpr float EPS = 1e-6f;
constexpr float LOG2E = 1.4426950408889634f;

constexpr size_t MiB = 1u << 20;
constexpr size_t WS_MOD = 1 * MiB;
constexpr size_t WS_ROPE = 4 * MiB;
constexpr size_t WS_MODP = 5 * MiB;
constexpr size_t WS_WSB = 25 * MiB;
constexpr size_t WS_DFTC = 26 * MiB;
constexpr size_t WS_WGU = 27 * MiB;
constexpr size_t WS_WD = 115 * MiB;
constexpr size_t WS_WINAB = 159 * MiB;
constexpr size_t WS_WINCD = 170 * MiB;
constexpr size_t WS_WOUT = 177 * MiB;
constexpr size_t WS_DFT = 185 * MiB;
constexpr size_t WS_XC = 249 * MiB;
constexpr size_t WS_H = 265 * MiB;
constexpr size_t WS_BIG = 401 * MiB;
constexpr size_t WS_VT = 707 * MiB;
constexpr size_t WS_FT = 809 * MiB;
constexpr size_t WS_FTC = 873 * MiB;
constexpr size_t WS_HS = 877 * MiB;
constexpr size_t WS_END = 1013 * MiB;

constexpr int LDS_BYTES = 131072 + 1024;

DI unsigned pk2(float lo, float hi) { f32x2 v = {lo, hi}; bf16x2_t b = __builtin_convertvector(v, bf16x2_t); return __builtin_bit_cast(unsigned, b); }
DI float bf2f(short s) { return __uint_as_float(((unsigned)(unsigned short)s) << 16); }
DI float wave_sum(float v) {
#pragma unroll
    for (int o = 1; o < 64; o <<= 1) v += __shfl_xor(v, o);
    return v;
}
DI float silu_f(float x) { return x * __builtin_amdgcn_rcpf(1.0f + __expf(-x)); }
DI float gelu_f(float x) { const float y = 0.7978845608028654f * (x + 0.044715f * x * x * x); return x * __builtin_amdgcn_rcpf(1.0f + __expf(-2.0f * y)); }

namespace pg8 {
constexpr int BM = 256, BK = 64, HALF = 128, HTB = HALF * BK * 2, STAGE_BYTES = 8 * HTB, NXCD = 8, WGM = 4;
DI int lds_byte(int r, int c) { const int st = (r >> 4) * 2 + (c >> 5), rr = r & 15, cc = c & 31, ob = rr * 64 + cc * 2; return st * 1024 + (ob ^ (((ob >> 9) & 1) << 5)); }
DI void stage_rc(int b, int& R, int& C) { const int st = b / 1024, sb = b % 1024, swz = sb ^ (((sb >> 9) & 1) << 5); R = (st >> 1) * 16 + swz / 64; C = (st & 1) * 32 + (swz % 64) / 2; }
DI int perm32(int rho) { const int n = rho >> 4, i = rho & 15; return 8 * (i >> 2) + 4 * n + (i & 3); }

struct Unit { int pm, pn, pz; };
struct Gemm { const bf16_t* A; const bf16_t* Bt; int lda, ldb, K; size_t zA, zB; };
struct Order {
    int nM, nN, per, nwg, G, c, pm0, fmode;
    DI void init(int nM_, int nN_, int nZ, int G_, int c_, int pm0_ = 0) { nM = nM_; nN = nN_; per = nM_ * nN_; nwg = per * nZ; G = G_; c = c_; pm0 = pm0_; fmode = 0; }
    DI void init_fourier(int G_, int c_) { nM = 2; nN = TT / 256; per = 304; nwg = 304; G = G_; c = c_; pm0 = 3; fmode = 1; }
    DI bool next(int i, Unit& u) const {
        const long L = (long)i * G + c; if (L >= nwg) return false;
        if (fmode) { const int w = (int)L; u.pz = 0;
            if (w < 272) { const int b = w / 17, r = w % 17; if (r < 9) { u.pm = 3; u.pn = b * 16 + r; } else { u.pm = 4; u.pn = b * 16 + r - 1; } }
            else { const int cq = w - 272; u.pm = 3 + (cq & 1); u.pn = TL / 256 + (cq >> 1); }
            return true; }
        int wgid = (int)L; { const int q = nwg / NXCD, r = nwg % NXCD, xcd = wgid % NXCD, off = wgid / NXCD; wgid = (xcd < r ? xcd * (q + 1) : r * (q + 1) + (xcd - r) * q) + off; }
        u.pz = wgid / per; const int w = wgid % per;
        const int nig = WGM * nN, gid = w / nig, fm = gid * WGM, gsz = (nM - fm) < WGM ? (nM - fm) : WGM;
        u.pm = pm0 + fm + ((w % nig) % gsz); u.pn = (w % nig) / gsz; return true;
    }
};
DI const char* a_of(const Gemm& g, const Unit& u) { return (const char*)(g.A + (size_t)u.pz * g.zA + (size_t)u.pm * BM * g.lda); }
DI const char* b_of(const Gemm& g, const Unit& u) { return (const char*)(g.Bt + (size_t)u.pz * g.zB + (size_t)u.pn * BM * g.ldb); }

template <class Epi>
DI void gemm_phase(LAS unsigned char* lds, int tid, const Gemm g, const Order& S, const Epi& E) {
    const int wid = __builtin_amdgcn_readfirstlane(tid >> 6), lane = tid & 63, wr = wid >> 2, wc = wid & 3, fr = lane & 15, fq = lane >> 4;
    const int K = g.K, nt = K / BK;
    unsigned voffA[2], voffB[2];
#pragma unroll
    for (int i = 0; i < 2; ++i) { int R, C; stage_rc(tid * 16 + i * 8192, R, C); const int Rb = (R & ~31) + perm32(R & 31);
        voffA[i] = (unsigned)(R * g.lda + C) * 2u; voffB[i] = (unsigned)(Rb * g.ldb + C) * 2u; }
    const size_t kstep = (size_t)(BK * 2);
    const size_t hstepA = (size_t)HALF * g.lda * 2, hstepB = (size_t)HALF * g.ldb * 2;
    const unsigned ldsw = (unsigned)wid * 1024u;
    const int aoff = lds_byte(wr * 64 + fr, fq * 8), boff = lds_byte(wc * 32 + fr, fq * 8);
#define PG8_SA(b, h) (((b) * 2 + (h)) * HTB)
#define PG8_SB(b, h) ((4 + (b) * 2 + (h)) * HTB)
#define PG8_STAGE(bufoff, gbase, voff) do { _Pragma("unroll") for (int _i = 0; _i < 2; ++_i) \
        __builtin_amdgcn_global_load_lds((const unsigned*)((const char*)(gbase) + (voff)[_i]), (LAS unsigned*)(lds + (bufoff) + ldsw + _i * 8192), 16, 0, 0); } while (0)
#define PG8_LDA(dst, b, h) do { _Pragma("unroll") for (int m = 0; m < 4; ++m) _Pragma("unroll") for (int k = 0; k < 2; ++k) dst[m][k] = *(const LAS bf16x8*)(lds + PG8_SA(b, h) + aoff + m * 2048 + k * 1024); } while (0)
#define PG8_LDB(dst, b, h) do { _Pragma("unroll") for (int n = 0; n < 2; ++n) _Pragma("unroll") for (int k = 0; k < 2; ++k) dst[n][k] = *(const LAS bf16x8*)(lds + PG8_SB(b, h) + boff + n * 2048 + k * 1024); } while (0)
#define PG8_MMA(ai, bj, At, Bt) do { __builtin_amdgcn_s_setprio(1); _Pragma("unroll") for (int m = 0; m < 4; ++m) _Pragma("unroll") for (int n = 0; n < 2; ++n) _Pragma("unroll") for (int k = 0; k < 2; ++k) \
        acc[ai][bj][m][n] = __builtin_amdgcn_mfma_f32_16x16x32_bf16(Bt[n][k], At[m][k], acc[ai][bj][m][n], 0, 0, 0); __builtin_amdgcn_s_setprio(0); } while (0)
#define PG8_WAIT_V(n) asm volatile("s_waitcnt vmcnt(" #n ")" ::: "memory")
#define PG8_WAIT_L(n) asm volatile("s_waitcnt lgkmcnt(" #n ")" ::: "memory")
#define PG8_BAR __builtin_amdgcn_s_barrier()
#define PG8_SCHED __builtin_amdgcn_sched_barrier(0)
    __syncthreads();
    Unit cur, nxt; int ui = 0;
    if (!S.next(0, cur)) return;
    f32x4 acc[2][2][4][2];
#pragma unroll
    for (int a = 0; a < 2; ++a)
#pragma unroll
        for (int b = 0; b < 2; ++b)
#pragma unroll
            for (int m = 0; m < 4; ++m)
#pragma unroll
                for (int n = 0; n < 2; ++n) acc[a][b][m][n] = (f32x4){0.f, 0.f, 0.f, 0.f};
    bf16x8 At[4][2], B0[2][2], B1[2][2];
    const char* cA = a_of(g, cur); const char* cB = b_of(g, cur);
    PG8_STAGE(PG8_SB(0, 0), cB, voffB); PG8_STAGE(PG8_SB(0, 1), cB + hstepB, voffB); PG8_STAGE(PG8_SA(0, 0), cA, voffA); PG8_STAGE(PG8_SA(0, 1), cA + hstepA, voffA);
    if (wr == 1) PG8_BAR;
    PG8_WAIT_V(2); PG8_BAR;
    PG8_STAGE(PG8_SB(1, 0), cB + kstep, voffB); PG8_STAGE(PG8_SA(1, 0), cA + kstep, voffA); PG8_STAGE(PG8_SB(1, 1), cB + hstepB + kstep, voffB);
    PG8_WAIT_V(6); PG8_BAR;
#pragma unroll 1
    for (;;) {
        const bool has_next = S.next(ui + 1, nxt);
        const char* nA = has_next ? a_of(g, nxt) : cA; const char* nB = has_next ? b_of(g, nxt) : cB;
#pragma unroll 1
        for (int t = 0; t < nt; t += 2) {
            const bool last = (t == nt - 2);
            const char* a1 = cA + (size_t)(t + 1) * kstep;
            const char* a2 = last ? nA : cA + (size_t)(t + 2) * kstep; const char* b2 = last ? nB : cB + (size_t)(t + 2) * kstep;
            const char* a3 = a2 + kstep; const char* b3 = b2 + kstep;
            PG8_LDB(B0, 0, 0); PG8_LDB(B1, 0, 1); PG8_SCHED; PG8_LDA(At, 0, 0); PG8_STAGE(PG8_SA(1, 1), a1 + hstepA, voffA);
            PG8_WAIT_V(8); PG8_WAIT_L(0); PG8_BAR; PG8_MMA(0, 0, At, B0); PG8_MMA(0, 1, At, B1); PG8_BAR; PG8_SCHED;
            PG8_LDA(At, 0, 1); PG8_STAGE(PG8_SB(0, 0), b2, voffB); PG8_STAGE(PG8_SB(0, 1), b2 + hstepB, voffB); PG8_STAGE(PG8_SA(0, 0), a2, voffA);
            PG8_WAIT_V(8); PG8_WAIT_L(0); PG8_BAR; PG8_MMA(1, 0, At, B0); PG8_MMA(1, 1, At, B1); PG8_BAR; PG8_SCHED;
            PG8_LDB(B0, 1, 0); PG8_LDB(B1, 1, 1); PG8_SCHED; PG8_LDA(At, 1, 0); PG8_STAGE(PG8_SA(0, 1), a2 + hstepA, voffA);
            PG8_WAIT_V(8); PG8_WAIT_L(0); PG8_BAR; PG8_MMA(0, 0, At, B0); PG8_MMA(0, 1, At, B1); PG8_BAR; PG8_SCHED;
            PG8_LDA(At, 1, 1); PG8_STAGE(PG8_SB(1, 0), b3, voffB); PG8_STAGE(PG8_SB(1, 1), b3 + hstepB, voffB); PG8_STAGE(PG8_SA(1, 0), a3, voffA);
            PG8_WAIT_V(8); PG8_WAIT_L(0); PG8_BAR; PG8_MMA(1, 0, At, B0); PG8_MMA(1, 1, At, B1); PG8_BAR; PG8_SCHED;
        }
        if (wr == 0) PG8_BAR;
        E(acc, cur, wr, wc, fr, fq);
        if (!has_next) break;
#pragma unroll
        for (int a = 0; a < 2; ++a)
#pragma unroll
            for (int b = 0; b < 2; ++b)
#pragma unroll
                for (int m = 0; m < 4; ++m)
#pragma unroll
                    for (int n = 0; n < 2; ++n) acc[a][b][m][n] = (f32x4){0.f, 0.f, 0.f, 0.f};
        cur = nxt; cA = nA; cB = nB; ++ui;
        if (wr == 1) PG8_BAR;
    }
    PG8_WAIT_V(0);
    PG8_BAR;
#undef PG8_SA
#undef PG8_SB
#undef PG8_STAGE
#undef PG8_LDA
#undef PG8_LDB
#undef PG8_MMA
#undef PG8_WAIT_V
#undef PG8_WAIT_L
#undef PG8_BAR
#undef PG8_SCHED
}

struct EpiSwiGLU {
    bf16_t* O;
    DI void operator()(const f32x4 (&acc)[2][2][4][2], const Unit& u, int wr, int wc, int fr, int fq) const {
        const int row0 = u.pm * BM + wr * 64 + fr, col0 = u.pn * 128 + wc * 32 + 8 * fq;
#pragma unroll
        for (int ai = 0; ai < 2; ++ai)
#pragma unroll
            for (int m = 0; m < 4; ++m) {
                bf16_t* rowp = O + (size_t)(row0 + ai * HALF + m * 16) * DFF + col0;
                const f32x4 g0 = acc[ai][0][m][0], g1 = acc[ai][0][m][1], u0 = acc[ai][1][m][0], u1 = acc[ai][1][m][1];
                u32x4 w;
                f32x4 e0, e1;
#pragma unroll
                for (int e = 0; e < 4; ++e) { e0[e] = __builtin_amdgcn_exp2f(-g0[e]); e1[e] = __builtin_amdgcn_exp2f(-g1[e]); }
                e0 = e0 + 1.0f; e1 = e1 + 1.0f;
#pragma unroll
                for (int e = 0; e < 4; ++e) { e0[e] = __builtin_amdgcn_rcpf(e0[e]); e1[e] = __builtin_amdgcn_rcpf(e1[e]); }
                const f32x4 r0 = g0 * u0 * e0, r1 = g1 * u1 * e1;
                w.x = pk2(r0[0], r0[1]); w.y = pk2(r0[2], r0[3]); w.z = pk2(r1[0], r1[1]); w.w = pk2(r1[2], r1[3]);
                *(u32x4*)rowp = w;
            }
    }
};
struct EpiStore {
    bf16_t* O; int ldc; size_t zO; float scale;
    DI void operator()(const f32x4 (&acc)[2][2][4][2], const Unit& u, int wr, int wc, int fr, int fq) const {
        const int row0 = u.pm * BM + wr * 64 + fr, col0 = u.pn * BM + wc * 32 + 8 * fq;
        bf16_t* base = O + (size_t)u.pz * zO;
#pragma unroll
        for (int ai = 0; ai < 2; ++ai)
#pragma unroll
            for (int m = 0; m < 4; ++m) {
                bf16_t* rowp = base + (size_t)(row0 + ai * HALF + m * 16) * ldc + col0;
#pragma unroll
                for (int bj = 0; bj < 2; ++bj) {
                    const f32x4 v0 = acc[ai][bj][m][0] * scale, v1 = acc[ai][bj][m][1] * scale;
                    u32x4 w; w.x = pk2(v0[0], v0[1]); w.y = pk2(v0[2], v0[3]); w.z = pk2(v1[0], v1[1]); w.w = pk2(v1[2], v1[3]);
                    *(u32x4*)(rowp + bj * HALF) = w;
                }
            }
    }
};
struct EpiResid {
    const float* srcL; const float* srcC; float* dstL; float* dstC; const float* gate; float coef;
    DI void operator()(const f32x4 (&acc)[2][2][4][2], const Unit& u, int wr, int wc, int fr, int fq) const {
        const bool isc = u.pm >= (TL / BM);
        const int bi = isc ? 16 : (u.pm >> 4);
        const int rloc = (isc ? (u.pm - TL / BM) : u.pm) * BM + wr * 64 + fr;
        const float* src = isc ? srcC : srcL; float* dst = isc ? dstC : dstL;
        const int col0 = u.pn * BM + wc * 32 + 8 * fq;
        const float* gp = gate + (size_t)bi * MODW + col0;
        f32x4 gv[2][2];
#pragma unroll
        for (int bj = 0; bj < 2; ++bj)
#pragma unroll
            for (int n = 0; n < 2; ++n) gv[bj][n] = *(const f32x4*)(gp + bj * HALF + 4 * n) * coef;
#pragma unroll
        for (int ai = 0; ai < 2; ++ai)
#pragma unroll
            for (int mp = 0; mp < 2; ++mp) {
                f32x4 sv[2][2][2];
#pragma unroll
                for (int m = 0; m < 2; ++m)
#pragma unroll
                    for (int bj = 0; bj < 2; ++bj)
#pragma unroll
                        for (int n = 0; n < 2; ++n) sv[m][bj][n] = *(const f32x4*)(src + (size_t)(rloc + ai * HALF + (2 * mp + m) * 16) * DM + col0 + bj * HALF + 4 * n);
#pragma unroll
                for (int m = 0; m < 2; ++m)
#pragma unroll
                    for (int bj = 0; bj < 2; ++bj)
#pragma unroll
                        for (int n = 0; n < 2; ++n) *(f32x4*)(dst + (size_t)(rloc + ai * HALF + (2 * mp + m) * 16) * DM + col0 + bj * HALF + 4 * n) = sv[m][bj][n] + gv[bj][n] * acc[ai][bj][2 * mp + m][n];
            }
    }
};
struct EpiFT {
    static constexpr bool HAS_POST = false;
    bf16_t* FT; bf16_t* FTC; bf16_t* VT;
    DI void operator()(const f32x4 (&acc)[2][2][4][2], const Unit& u, int wr, int wc, int fr, int fq) const {
        const bool isc = u.pn >= (TL / BM);
        bf16_t* base; size_t ld;
        if (u.pm < 3) { base = VT + (size_t)(u.pm * BM) * TT + (size_t)u.pn * BM; ld = TT; }
        else if (!isc) {
            const int b = u.pn >> 4, vt = u.pn & 15, part = u.pm - 3;
            if ((part == 0 && vt > 8) || (part == 1 && vt < 8)) return;
            base = FT + (size_t)b * 256 * 4096 + vt * BM; ld = 4096;
            if (vt == 8) {
                const int n0_ = wr * 64 + fr, c0_ = wc * 32 + 8 * fq;
#pragma unroll
                for (int ai = 0; ai < 2; ++ai)
#pragma unroll
                    for (int m = 0; m < 4; ++m) { bf16_t* rowp = base + (size_t)(n0_ + ai * HALF + m * 16) * ld + c0_;
#pragma unroll
                        for (int bj = 0; bj < 2; ++bj) { const f32x4 v0 = acc[ai][bj][m][0], v1 = acc[ai][bj][m][1];
                            const float ev[8] = {v0[0], v0[1], v0[2], v0[3], v1[0], v1[1], v1[2], v1[3]};
#pragma unroll
                            for (int e = 0; e < 8; ++e) { const int v = 2048 + bj * HALF + c0_ + e; const bool keep = part == 0 ? (v <= 2048) : (v > 2048);
                                if (keep) rowp[bj * HALF + e] = (bf16_t)(pk2(ev[e], 0.f) & 0xffffu); } } }
                return;
            }
        }
        else { const int b = u.pn - TL / BM; base = FTC + (size_t)b * 256 * 512 + (size_t)(u.pm - 3) * CTXL; ld = 512; }
        const int n0 = wr * 64 + fr, c0 = wc * 32 + 8 * fq;
#pragma unroll
        for (int ai = 0; ai < 2; ++ai)
#pragma unroll
            for (int m = 0; m < 4; ++m) {
                bf16_t* rowp = base + (size_t)(n0 + ai * HALF + m * 16) * ld + c0;
#pragma unroll
                for (int bj = 0; bj < 2; ++bj) {
                    const f32x4 v0 = acc[ai][bj][m][0], v1 = acc[ai][bj][m][1];
                    u32x4 w; w.x = pk2(v0[0], v0[1]); w.y = pk2(v0[2], v0[3]); w.z = pk2(v1[0], v1[1]); w.w = pk2(v1[2], v1[3]);
                    *(u32x4*)(rowp + bj * HALF) = w;
                }
            }
    }
};
}

struct Args { const float* in[19]; float* out; unsigned char* ws; };
struct Frame {
    LAS unsigned char* lds;
    int tid, lane, wave, vcu, G;
    float* out; unsigned char* ws;
};
#define WSP(T, off) ((T*)(F.ws + (off)))
DI const float* in_ptr(const Args& AR, int i) { asm volatile("" : "+s"(i)); return GLOBAL_PTR(const float, AR.in[i]); }

DI void transpose_item(const float* W, int ldw, int K, int nblk, bf16_t* WT, int mode, LAS float* scr, int item, int lane) {
    const int kb = item / nblk, nb = item % nblk, k0 = 64 * kb, n0 = 32 * nb;
    float wv[32];
#pragma unroll
    for (int i = 0; i < 32; ++i) wv[i] = W[(size_t)(k0 + 2 * i + (lane >> 5)) * ldw + n0 + (lane & 31)];
#pragma unroll
    for (int i = 0; i < 32; ++i) { const int kk = 2 * i + (lane >> 5); scr[kk * 33 + (lane & 31)] = wv[i]; }
    LDS_WAIT();
    int rbase = n0; float wsc = 1.0f;
    if (mode == 1) { if (n0 < DFF) { rbase = (n0 >> 7) * 256 + (n0 & 127); wsc = LOG2E; } else { const int j = n0 - DFF; rbase = (j >> 7) * 256 + 128 + (j & 127); wsc = 1.0f / LOG2E; } }
    const int c = lane & 7;
#pragma unroll
    for (int j = 0; j < 4; ++j) { const int n = (lane >> 3) + 8 * j; const LAS float* s = scr + (8 * c) * 33 + n;
        u32x4 o; o.x = pk2(s[0 * 33] * wsc, s[1 * 33] * wsc); o.y = pk2(s[2 * 33] * wsc, s[3 * 33] * wsc); o.z = pk2(s[4 * 33] * wsc, s[5 * 33] * wsc); o.w = pk2(s[6 * 33] * wsc, s[7 * 33] * wsc);
        *(u32x4*)(WT + (size_t)(rbase + n) * K + k0 + 8 * c) = o; }
    LDS_WAIT();
}

DI void prologue_a(Frame& F, const Args& AR, int ps_lo, int ps_hi) {
    LAS float* scr = (LAS float*)(F.lds + F.wave * 16384);
    LAS float* tw = (LAS float*)(F.lds + 131072);
    if (F.tid < 64) { tw[F.tid] = cospif((float)F.tid * (1.0f / 32.0f)); tw[64 + F.tid] = sinpif((float)F.tid * (1.0f / 32.0f)); }
    __syncthreads();
#pragma unroll 1
    for (int ps = ps_lo; ps < ps_hi; ++ps) {
    { int t_ = F.tid; asm volatile("" : "+v"(t_)); F.tid = t_; F.lane = t_ & 63; unsigned char* w_ = F.ws; asm volatile("" : "+s"(w_)); F.ws = GLOBAL_PTR(unsigned char, w_); }
    const int gw = F.vcu * 8 + F.wave, NGW = F.G * 8;
    const int gt = F.vcu * 512 + F.tid, NGT = F.G * 512;
    if (ps == 0) {
    constexpr int I0 = 8 * 16 * 176, I1 = 8 * 44 * 32, I2 = 2 * 16 * 72, I3 = 2 * 16 * 56, I4 = 4 * 16 * 32;
    for (int it = gw; it < I0 + I1 + I2 + I3 + I4; it += NGW) {
        int r = it;
        if (r < I0) { const int mt = r / (16 * 176), ii = r % (16 * 176); transpose_item(in_ptr(AR, 7) + (size_t)mt * DM * 2 * DFF, 2 * DFF, DM, 176, WSP(bf16_t, WS_WGU) + (size_t)mt * 2 * DFF * DM, 1, scr, ii, F.lane); continue; } r -= I0;
        if (r < I1) { const int mt = r / (44 * 32), ii = r % (44 * 32); transpose_item(in_ptr(AR, 8) + (size_t)mt * DFF * DM, DM, DFF, 32, WSP(bf16_t, WS_WD) + (size_t)mt * DM * DFF, 0, scr, ii, F.lane); continue; } r -= I1;
        if (r < I2) { const int mt = r / (16 * 72), ii = r % (16 * 72); transpose_item(in_ptr(AR, 9) + (size_t)mt * DM * 2560, 2560, DM, 72, WSP(bf16_t, WS_WINAB) + (size_t)mt * 2816 * DM, 0, scr, ii, F.lane); continue; } r -= I2;
        if (r < I3) { const int mt = r / (16 * 56), ii = r % (16 * 56); transpose_item(in_ptr(AR, 13) + (size_t)mt * DM * 1792, 1792, DM, 56, WSP(bf16_t, WS_WINCD) + (size_t)mt * 1792 * DM, 0, scr, ii, F.lane); continue; } r -= I3;
        { const int mt = r / (16 * 32), ii = r % (16 * 32); const float* src = (mt & 1) ? in_ptr(AR, 14) + (size_t)(mt >> 1) * DM * DM : in_ptr(AR, 10) + (size_t)(mt >> 1) * DM * DM;
          transpose_item(src, DM, DM, 32, WSP(bf16_t, WS_WOUT) + (size_t)mt * DM * DM, 0, scr, ii, F.lane); }
    }
    } else if (ps == 1) {
    for (int it = gw; it < 128; it += NGW) {
        const int i = it >> 6, g = (it >> 4) & 3, kb = it & 15, k = kb * 64 + F.lane;
        const float* wrow = in_ptr(AR, 9) + ((size_t)i * DM + k) * 2560 + 2304 + g * 64;
        float w[64];
#pragma unroll
        for (int c4 = 0; c4 < 16; ++c4) { const f32x4 v = *(const f32x4*)(wrow + 4 * c4); w[4 * c4] = v[0]; w[4 * c4 + 1] = v[1]; w[4 * c4 + 2] = v[2]; w[4 * c4 + 3] = v[3]; }
        bf16_t* WT = WSP(bf16_t, WS_WINAB) + (size_t)i * 2816 * DM;
        for (int cp = 0; cp < 64; ++cp) {
            float sc = 0.f, ss = 0.f;
#pragma unroll
            for (int c = 0; c < 64; ++c) { const int idx = (c * cp) & 63; sc += w[c] * tw[idx]; ss += w[c] * tw[64 + idx]; }
            WT[(size_t)(2304 + g * 64 + cp) * DM + k] = (bf16_t)(pk2(sc, 0.f) & 0xffffu);
            WT[(size_t)(2560 + g * 64 + cp) * DM + k] = (bf16_t)(pk2(ss, 0.f) & 0xffffu);
        }
    }
    } else if (ps == 2) {
    { const float* s = in_ptr(AR, 17); bf16_t* d = WSP(bf16_t, WS_WSB);
      for (int i = gt; i < 2 * 4 * 128 * 128 / 2; i += NGT) { const f32x2 v = *(const f32x2*)(s + 2 * i); ((unsigned*)d)[i] = pk2(v[0], v[1]); } }
    } else if (ps == 3) {
    { bf16_t* d = WSP(bf16_t, WS_DFT);
      for (int i = gt; i < SEQ * 512; i += NGT) { const int tp = i >> 9, k8 = (i & 511) * 8; float v[8];
#pragma unroll
          for (int e = 0; e < 8; ++e) { const int kk = k8 + e; const int k = kk <= 2048 ? kk : kk - 2048; const int j = (tp * k) & 4095; const float a = (float)j * (1.0f / 2048.0f); v[e] = (kk <= 2048) ? cospif(a) : -sinpif(a); }
          u32x4 o; o.x = pk2(v[0], v[1]); o.y = pk2(v[2], v[3]); o.z = pk2(v[4], v[5]); o.w = pk2(v[6], v[7]); *(u32x4*)(d + (size_t)i * 8) = o; }
      bf16_t* dc = WSP(bf16_t, WS_DFTC);
      for (int i = gt; i < CTXL * 64; i += NGT) { const int tp = i >> 6, k8 = (i & 63) * 8; float v[8];
#pragma unroll
          for (int e = 0; e < 8; ++e) { const int k = k8 + e; const int j = (tp * (k & 255)) & 255; const float a = (float)j * (1.0f / 128.0f); v[e] = (k < CTXL) ? cospif(a) : -sinpif(a); }
          u32x4 o; o.x = pk2(v[0], v[1]); o.y = pk2(v[2], v[3]); o.z = pk2(v[4], v[5]); o.w = pk2(v[6], v[7]); *(u32x4*)(dc + (size_t)i * 8) = o; } }
    } else if (ps == 4) {
    { float* rp = WSP(float, WS_ROPE);
      for (int i = gt; i < 1024; i += NGT) { const int pos = i >> 4, f = i & 15; const float inv = exp2f(-(float)f * (13.287712379549449f / 16.0f));
          const float ang = (float)pos * inv; const float rev = ang * 0.15915494309189535f; const float fr = rev - floorf(rev);
          rp[2 * i] = cospif(2.0f * fr); rp[2 * i + 1] = sinpif(2.0f * fr); } }
    } else {
    for (int it = gw; it < 4 * 36 * 8; it += NGW) {
        const int l = it / 288, rem = it % 288, cgp = rem >> 3, kc = rem & 7;
        LAS float* sl = scr;
        for (int e = F.lane; e < NBI * 128; e += 64) { const int bi = e >> 7, kk = e & 127; const float cv = bi < 16 ? in_ptr(AR, 1)[bi * DM + kc * 128 + kk] : in_ptr(AR, 3)[kc * 128 + kk]; sl[e] = silu_f(cv); }
        LDS_WAIT();
        f32x4 acc[NBI];
#pragma unroll
        for (int bi = 0; bi < NBI; ++bi) acc[bi] = (f32x4){0.f, 0.f, 0.f, 0.f};
        const int col = cgp * 256 + F.lane * 4;
        const float* wp = in_ptr(AR, 5) + ((size_t)l * DM + kc * 128) * MODW + col;
#pragma unroll 4
        for (int kk = 0; kk < 128; ++kk) { const f32x4 w = *(const f32x4*)(wp + (size_t)kk * MODW);
#pragma unroll
            for (int bi = 0; bi < NBI; ++bi) acc[bi] += w * sl[bi * 128 + kk]; }
        float* dp = WSP(float, WS_MODP) + (size_t)kc * (4 * NBI * MODW) + (size_t)l * NBI * MODW + col;
#pragma unroll
        for (int bi = 0; bi < NBI; ++bi) *(f32x4*)(dp + (size_t)bi * MODW) = acc[bi];
        LDS_WAIT();
    }
    }
    }
}
DI void prologue_b(Frame& F, const Args& AR) {
    const int gt = F.vcu * 512 + F.tid, NGT = F.G * 512;
    const float* mp = WSP(float, WS_MODP); float* md = WSP(float, WS_MOD);
    for (int i = gt; i < 4 * NBI * MODW / 4; i += NGT) {
        const int l = i / (NBI * MODW / 4), n4 = i % (MODW / 4);
        f32x4 s = *(const f32x4*)(in_ptr(AR, 6) + (size_t)l * MODW + 4 * n4);
#pragma unroll
        for (int kc = 0; kc < 8; ++kc) s += *(const f32x4*)(mp + (size_t)kc * (4 * NBI * MODW) + (size_t)i * 4);
        *(f32x4*)(md + (size_t)i * 4) = s;
    }
}

DI void norm_phase(Frame& F, const float* srcL, const float* srcC, const float* g, const float* modl, int sub) {
    const int gw = F.vcu * 8 + F.wave; constexpr int RPW = TT / 2048;
    bf16_t* H = WSP(bf16_t, WS_H);
    int cur_bi = -1; f32x4 gs[4], sh[4];
    for (int row = gw * RPW; row < gw * RPW + RPW; ++row) {
        const int bi = row < TL ? (row >> 12) : 16;
        if (bi != cur_bi) { cur_bi = bi; const float* mp = modl + (size_t)bi * MODW + sub * 3072;
#pragma unroll
            for (int j = 0; j < 4; ++j) { const int k = (F.lane + 64 * j) * 4; const f32x4 gg = *(const f32x4*)(g + k), sc = *(const f32x4*)(mp + 1024 + k); sh[j] = *(const f32x4*)(mp + k); gs[j] = gg * (sc + 1.0f); } }
        const float* src = row < TL ? srcL + (size_t)row * DM : srcC + (size_t)(row - TL) * DM;
        f32x4 v[4]; float ss = 0.f;
#pragma unroll
        for (int j = 0; j < 4; ++j) { v[j] = *(const f32x4*)(src + (F.lane + 64 * j) * 4); ss += (v[j][0] * v[j][0] + v[j][1] * v[j][1]) + (v[j][2] * v[j][2] + v[j][3] * v[j][3]); }
        const float rstd = rsqrtf(wave_sum(ss) * (1.0f / DM) + EPS);
        bf16_t* hp = H + (size_t)row * DM;
#pragma unroll
        for (int j = 0; j < 4; ++j) { const f32x4 o = v[j] * rstd * gs[j] + sh[j]; u32x2 w; w.x = pk2(o[0], o[1]); w.y = pk2(o[2], o[3]); *(u32x2*)(hp + (F.lane + 64 * j) * 4) = w; }
    }
}

DI void norm_pair_phase(Frame& F, const float* srcL, const float* srcC, const float* g, const float* modl, int sub) {
    bf16_t* H = WSP(bf16_t, WS_H); bf16_t* HS = WSP(bf16_t, WS_HS);
    const int gw = F.vcu * 8 + F.wave, NGW = F.G * 8, lane = F.lane;
    int cur_bi = -1; f32x4 gs[4], sh[4];
    const int NT_L = NB * 2049, NT = NT_L + TC / 2;
    for (int task = gw; task < NT; task += NGW) {
        int bi, r1, r2, j; bool single, isc = task >= NT_L;
        if (!isc) { bi = task / 2049; j = task % 2049; single = (j == 0 || j == 2048); r1 = bi * SEQ + j; r2 = single ? r1 : bi * SEQ + SEQ - j; }
        else { bi = 16; j = 0; single = false; r1 = TL + 2 * (task - NT_L); r2 = r1 + 1; }
        if (bi != cur_bi) { cur_bi = bi; const float* mp = modl + (size_t)bi * MODW + sub * 3072;
#pragma unroll
            for (int q = 0; q < 4; ++q) { const int k = (lane + 64 * q) * 4; const f32x4 gg = *(const f32x4*)(g + k), sc = *(const f32x4*)(mp + 1024 + k); sh[q] = *(const f32x4*)(mp + k); gs[q] = gg * (sc + 1.0f); } }
        const float* s1 = r1 < TL ? srcL + (size_t)r1 * DM : srcC + (size_t)(r1 - TL) * DM;
        const float* s2 = r2 < TL ? srcL + (size_t)r2 * DM : srcC + (size_t)(r2 - TL) * DM;
        f32x4 v1[4], v2[4]; float ss1 = 0.f, ss2 = 0.f;
#pragma unroll
        for (int q = 0; q < 4; ++q) { v1[q] = *(const f32x4*)(s1 + (lane + 64 * q) * 4); v2[q] = *(const f32x4*)(s2 + (lane + 64 * q) * 4); }
#pragma unroll
        for (int q = 0; q < 4; ++q) { ss1 += (v1[q][0] * v1[q][0] + v1[q][1] * v1[q][1]) + (v1[q][2] * v1[q][2] + v1[q][3] * v1[q][3]); ss2 += (v2[q][0] * v2[q][0] + v2[q][1] * v2[q][1]) + (v2[q][2] * v2[q][2] + v2[q][3] * v2[q][3]); }
#pragma unroll
        for (int o = 1; o < 64; o <<= 1) { ss1 += __shfl_xor(ss1, o); ss2 += __shfl_xor(ss2, o); }
        const float rs1 = rsqrtf(ss1 * (1.0f / DM) + EPS), rs2 = rsqrtf(ss2 * (1.0f / DM) + EPS);
        bf16_t* h1 = H + (size_t)r1 * DM; bf16_t* h2 = H + (size_t)r2 * DM;
        bf16_t* hp = HS + (size_t)(isc ? r1 : bi * SEQ + j) * DM; bf16_t* hm = HS + (size_t)(isc ? r2 : bi * SEQ + 2048 + j) * DM;
#pragma unroll
        for (int q = 0; q < 4; ++q) {
            const f32x4 o1 = v1[q] * rs1 * gs[q] + sh[q], o2 = v2[q] * rs2 * gs[q] + sh[q];
            const int c = (lane + 64 * q) * 4;
            u32x2 w; w.x = pk2(o1[0], o1[1]); w.y = pk2(o1[2], o1[3]); *(u32x2*)(h1 + c) = w;
            if (!single) { u32x2 w2; w2.x = pk2(o2[0], o2[1]); w2.y = pk2(o2[2], o2[3]); *(u32x2*)(h2 + c) = w2; }
            if (isc) { *(u32x2*)(hp + c) = w; u32x2 w2; w2.x = pk2(o2[0], o2[1]); w2.y = pk2(o2[2], o2[3]); *(u32x2*)(hm + c) = w2; }
            else if (single) { *(u32x2*)(hp + c) = w; }
            else { const f32x4 sp = o1 + o2, sm = o1 - o2; u32x2 wp, wm; wp.x = pk2(sp[0], sp[1]); wp.y = pk2(sp[2], sp[3]); wm.x = pk2(sm[0], sm[1]); wm.y = pk2(sm[2], sm[3]);
                   *(u32x2*)(hp + c) = wp; *(u32x2*)(hm + c) = wm; }
        }
    }
}

DI void postpass(Frame& F, bool even, const float* qkg  ) {
    bf16_t* P = WSP(bf16_t, WS_BIG); bf16_t* VT = WSP(bf16_t, WS_VT);
    const int ldp = even ? LDP_E : LDP_O, kcol0 = even ? 768 : 512, nqk = even ? 12 : 2, vcol0 = 640, nvb = even ? 0 : 2;
    const float* rope = WSP(float, WS_ROPE);
    const int gt = F.vcu * 512 + F.tid, NGT = F.G * 512;
    const int total = TT * nqk;
    for (int idx = gt; idx < total; idx += NGT) {
        const int row = idx / nqk, hs = idx % nqk;
        bf16_t* p = P + (size_t)row * ldp + kcol0 + hs * 64;
        const float* gv = qkg + 64;
        bf16x8 raw[8]; float x[64]; float ss = 0.f;
#pragma unroll
        for (int j = 0; j < 8; ++j) raw[j] = *(const bf16x8*)(p + 8 * j);
#pragma unroll
        for (int j = 0; j < 8; ++j)
#pragma unroll
            for (int e = 0; e < 8; ++e) { const float v = bf2f(raw[j][e]); x[8 * j + e] = v; ss += v * v; }
        const float rstd = rsqrtf(ss * (1.0f / 64.0f) + EPS);
#pragma unroll
        for (int d = 0; d < 64; ++d) x[d] = x[d] * rstd * gv[d];
        if (!even && row < TL) {
            const int t = row & (SEQ - 1), pr = t >> 6, pc = t & 63;
#pragma unroll
            for (int i = 0; i < 32; ++i) { const f32x2 cs = *(const f32x2*)(rope + ((i < 16 ? pr : pc) * 16 + (i & 15)) * 2);
                const float x0 = x[2 * i], x1 = x[2 * i + 1]; x[2 * i] = x0 * cs[0] - x1 * cs[1]; x[2 * i + 1] = x0 * cs[1] + x1 * cs[0]; }
        }
#pragma unroll
        for (int j = 0; j < 8; ++j) { u32x4 w; w.x = pk2(x[8 * j], x[8 * j + 1]); w.y = pk2(x[8 * j + 2], x[8 * j + 3]); w.z = pk2(x[8 * j + 4], x[8 * j + 5]); w.w = pk2(x[8 * j + 6], x[8 * j + 7]); *(u32x4*)(p + 8 * j) = w; }
    }
    __syncthreads();
    LAS bf16_t* T = (LAS bf16_t*)(F.lds + F.wave * 16384);
    const int gw = F.vcu * 8 + F.wave, NGW = F.G * 8;
    for (int it = gw; it < (TT / 64) * nvb; it += NGW) {
        const int tt = it / nvb, cb = it % nvb;
        const bf16_t* src = P + (size_t)(tt * 64 + F.lane) * ldp + vcol0 + cb * 64;
#pragma unroll
        for (int j = 0; j < 8; ++j) { const bf16x8 v = *(const bf16x8*)(src + 8 * j);
#pragma unroll
            for (int e = 0; e < 8; ++e) T[(8 * j + e) * 72 + F.lane] = (bf16_t)v[e]; }
        LDS_WAIT();
        bf16_t* dst = VT + (size_t)(cb * 64 + F.lane) * TT + tt * 64;
#pragma unroll
        for (int j = 0; j < 8; ++j) { const u32x4 v = *(const LAS u32x4*)(T + F.lane * 72 + 8 * j); *(u32x4*)(dst + 8 * j) = v; }
        LDS_WAIT();
    }
}

template <bool ROPE>
DI void q_prep(bf16x8& q0, bf16x8& q1, const float* gq, int g, const float* rope, int t) {
    float x[16]; float ss = 0.f;
#pragma unroll
    for (int e = 0; e < 8; ++e) { x[e] = bf2f(q0[e]); x[8 + e] = bf2f(q1[e]); ss += x[e] * x[e] + x[8 + e] * x[8 + e]; }
    ss += __shfl_xor(ss, 16); ss += __shfl_xor(ss, 32);
    const float rstd = rsqrtf(ss * (1.0f / 64.0f) + EPS);
    const f32x4 ga = *(const f32x4*)(gq + 8 * g), gb = *(const f32x4*)(gq + 8 * g + 4), gc = *(const f32x4*)(gq + 32 + 8 * g), gd = *(const f32x4*)(gq + 32 + 8 * g + 4);
#pragma unroll
    for (int e = 0; e < 4; ++e) { x[e] *= rstd * ga[e]; x[4 + e] *= rstd * gb[e]; x[8 + e] *= rstd * gc[e]; x[12 + e] *= rstd * gd[e]; }
    if (ROPE) {
        const float* rr = rope + ((t >> 6) * 16 + 4 * g) * 2; const float* rc = rope + ((t & 63) * 16 + 4 * g) * 2;
        const f32x4 r0 = *(const f32x4*)rr, r1 = *(const f32x4*)(rr + 4), c0 = *(const f32x4*)rc, c1 = *(const f32x4*)(rc + 4);
        const float cs[8] = {r0[0], r0[2], r1[0], r1[2], c0[0], c0[2], c1[0], c1[2]}, sn[8] = {r0[1], r0[3], r1[1], r1[3], c0[1], c0[3], c1[1], c1[3]};
#pragma unroll
        for (int i = 0; i < 8; ++i) { const float a = x[2 * i], b = x[2 * i + 1]; x[2 * i] = a * cs[i] - b * sn[i]; x[2 * i + 1] = a * sn[i] + b * cs[i]; }
    }
    u32x4 w0, w1; w0.x = pk2(x[0], x[1]); w0.y = pk2(x[2], x[3]); w0.z = pk2(x[4], x[5]); w0.w = pk2(x[6], x[7]); w1.x = pk2(x[8], x[9]); w1.y = pk2(x[10], x[11]); w1.z = pk2(x[12], x[13]); w1.w = pk2(x[14], x[15]);
    q0 = __builtin_bit_cast(bf16x8, w0); q1 = __builtin_bit_cast(bf16x8, w1);
}
struct KVf { bf16x8 k00, k01, k10, k11; };
struct VVf { bf16x8 v0, v1, v2, v3; };
DI bf16x8 ldv8(const bf16_t* p) { const s16x4 lo = *(const s16x4*)p, hi = *(const s16x4*)(p + 16); return (bf16x8){lo[0], lo[1], lo[2], lo[3], hi[0], hi[1], hi[2], hi[3]}; }
DI void k_load(KVf& f, const bf16_t* kp, size_t kpitch) {
    f.k00 = *(const bf16x8*)kp; f.k01 = *(const bf16x8*)(kp + 32); f.k10 = *(const bf16x8*)(kp + 16 * kpitch); f.k11 = *(const bf16x8*)(kp + 16 * kpitch + 32);
}
DI void v_load(VVf& f, const bf16_t* vp, size_t vpitch) {
    f.v0 = ldv8(vp); f.v1 = ldv8(vp + 16 * vpitch); f.v2 = ldv8(vp + 32 * vpitch); f.v3 = ldv8(vp + 48 * vpitch);
}
#define MFMA16(a, b, c) __builtin_amdgcn_mfma_f32_16x16x32_bf16((a), (b), (c), 0, 0, 0)
template <int NH, bool BIAS>
DI void attn_compute(f32x4 (&o)[NH][4], float (&mx)[NH], float (&ls)[NH], const bf16x8 (&q)[NH][2], const KVf& f, const VVf& fv, f32x4 b0, f32x4 b1, unsigned vm) {
    const f32x4 z = {0.f, 0.f, 0.f, 0.f};
    constexpr float C = 0.125f * LOG2E;
#pragma unroll
    for (int h = 0; h < NH; ++h) {
        f32x4 s0 = MFMA16(f.k00, q[h][0], z); s0 = MFMA16(f.k01, q[h][1], s0);
        f32x4 s1 = MFMA16(f.k10, q[h][0], z); s1 = MFMA16(f.k11, q[h][1], s1);
        s0 = s0 * C; s1 = s1 * C;
        if (BIAS) { s0 += b0; s1 += b1;
#pragma unroll
            for (int e = 0; e < 4; ++e) { if (!((vm >> e) & 1u)) s0[e] = -1e30f; if (!((vm >> (4 + e)) & 1u)) s1[e] = -1e30f; } }
        float t = fmaxf(fmaxf(fmaxf(s0[0], s0[1]), fmaxf(s0[2], s0[3])), fmaxf(fmaxf(s1[0], s1[1]), fmaxf(s1[2], s1[3])));
        t = fmaxf(t, __shfl_xor(t, 16)); t = fmaxf(t, __shfl_xor(t, 32));
        const float mn = fmaxf(mx[h], t); const float al = __builtin_amdgcn_exp2f(mx[h] - mn); mx[h] = mn;
        f32x4 p0, p1;
#pragma unroll
        for (int e = 0; e < 4; ++e) { p0[e] = __builtin_amdgcn_exp2f(s0[e] - mn); p1[e] = __builtin_amdgcn_exp2f(s1[e] - mn); }
        ls[h] = ls[h] * al + ((p0[0] + p0[1]) + (p0[2] + p0[3])) + ((p1[0] + p1[1]) + (p1[2] + p1[3]));
        u32x4 pw; pw.x = pk2(p0[0], p0[1]); pw.y = pk2(p0[2], p0[3]); pw.z = pk2(p1[0], p1[1]); pw.w = pk2(p1[2], p1[3]);
        const bf16x8 pb = __builtin_bit_cast(bf16x8, pw);
        o[h][0] = MFMA16(fv.v0, pb, o[h][0] * al); o[h][1] = MFMA16(fv.v1, pb, o[h][1] * al);
        o[h][2] = MFMA16(fv.v2, pb, o[h][2] * al); o[h][3] = MFMA16(fv.v3, pb, o[h][3] * al);
    }
}
template <int NH, bool BIAS>
DI void attn_unit(const bf16_t* qp, const bf16_t* kA, const bf16_t* vA, int nA, int strideA, const bf16_t* kB, const bf16_t* vB, int nB, size_t kpitch,
                  bf16_t* op  , const float* rpbh, int drow0, const int (&dc)[8], unsigned vmask, const float* gq, int g) {
    bf16x8 q[NH][2]; f32x4 o[NH][4]; float mx[NH], ls[NH];
#pragma unroll
    for (int h = 0; h < NH; ++h) { q[h][0] = *(const bf16x8*)(qp + h * 64); q[h][1] = *(const bf16x8*)(qp + h * 64 + 32); q_prep<false>(q[h][0], q[h][1], gq, g, nullptr, 0); mx[h] = -1e30f; ls[h] = 0.f;
#pragma unroll
        for (int d = 0; d < 4; ++d) o[h][d] = (f32x4){0.f, 0.f, 0.f, 0.f}; }
    const int n = nA + nB;
    const size_t vpitch = TT;
    KVf fa, fb; VVf fv;
#define SEG_K(s) ((s) < nA ? kA + (size_t)(s) * strideA * kpitch : kB + (size_t)((s) - nA) * 32 * kpitch)
#define SEG_V(s) ((s) < nA ? vA + (size_t)(s) * strideA : vB + (size_t)((s) - nA) * 32)
    k_load(fa, SEG_K(0), kpitch);
    for (int s = 0; s < n; s += 2) {
        v_load(fv, SEG_V(s), vpitch); k_load(fb, SEG_K(s + 1), kpitch);
        {
            f32x4 b0 = {0.f, 0.f, 0.f, 0.f}, b1 = b0; unsigned vm = 0xffu;
            if (BIAS && s < nA) { const float* rp = rpbh + (drow0 + s) * 31; vm = vmask;
#pragma unroll
                for (int e = 0; e < 4; ++e) { b0[e] = rp[dc[e]] * LOG2E; b1[e] = rp[dc[4 + e]] * LOG2E; } }
            attn_compute<NH, BIAS>(o, mx, ls, q, fa, fv, b0, b1, vm);
        }
        v_load(fv, SEG_V(s + 1), vpitch); if (s + 2 < n) k_load(fa, SEG_K(s + 2), kpitch);
        {
            f32x4 b0 = {0.f, 0.f, 0.f, 0.f}, b1 = b0; unsigned vm = 0xffu;
            if (BIAS && s + 1 < nA) { const float* rp = rpbh + (drow0 + s + 1) * 31; vm = vmask;
#pragma unroll
                for (int e = 0; e < 4; ++e) { b0[e] = rp[dc[e]] * LOG2E; b1[e] = rp[dc[4 + e]] * LOG2E; } }
            attn_compute<NH, BIAS>(o, mx, ls, q, fb, fv, b0, b1, vm);
        }
    }
#undef SEG_K
#undef SEG_V
#pragma unroll
    for (int h = 0; h < NH; ++h) {
        float l = ls[h]; l += __shfl_xor(l, 16); l += __shfl_xor(l, 32);
        const float inv = 1.0f / l;
#pragma unroll
        for (int d = 0; d < 4; ++d) { const f32x4 v = o[h][d] * inv; u32x2 w; w.x = pk2(v[0], v[1]); w.y = pk2(v[2], v[3]); *(u32x2*)(op + h * 64 + d * 16) = w; }
    }
}

DI void attn_even(Frame& F, const float* rpb  , const float* gq) {
    const bf16_t* P = WSP(bf16_t, WS_BIG); const bf16_t* VT = WSP(bf16_t, WS_VT); bf16_t* MIX = WSP(bf16_t, WS_H);
    const int l16 = F.lane & 15, g = F.lane >> 4;
    const size_t kp = LDP_E;
    const int gw = F.vcu * 8 + F.wave, NGW = F.G * 8;
    const int dz[8] = {0, 0, 0, 0, 0, 0, 0, 0};
    for (int wu = gw; wu < NB * 12 * 16; wu += NGW) {
        const int b = wu / 192, h = (wu % 192) >> 4, qb = wu & 15;
        const int qrow = TL + b * CTXL + qb * 16 + l16;
        const bf16_t* kB = P + (size_t)(TL + b * CTXL + l16) * kp + 768 + h * 64 + g * 8;
        const bf16_t* vB = VT + (size_t)(h * 64 + l16) * TT + TL + b * CTXL + 4 * g;
        attn_unit<1, false>(P + (size_t)qrow * kp + h * 64 + g * 8, kB, vB, 0, 32, kB, vB, 8, kp, MIX + (size_t)qrow * DM + h * 64 + 4 * g, rpb, 0, dz, 0xffu, gq, g);
    }
}
DI void attn_odd(Frame& F, const float* gq) {
    const bf16_t* P = WSP(bf16_t, WS_BIG); const bf16_t* VT = WSP(bf16_t, WS_VT); bf16_t* MIX = WSP(bf16_t, WS_H);
    const int l16 = F.lane & 15, g = F.lane >> 4;
    const size_t kp = LDP_O;
    const int dz[8] = {0, 0, 0, 0, 0, 0, 0, 0};
    const int gw = F.vcu * 8 + F.wave, NGW = F.G * 8;
    for (int wu = gw; wu < NB * 2 * 16; wu += NGW) {
        const int b = wu >> 5, kvh = (wu >> 4) & 1, qb = wu & 15;
        const int qrow = TL + b * CTXL + qb * 16 + l16;
        const bf16_t* kB = P + (size_t)(TL + b * CTXL + l16) * kp + 512 + kvh * 64 + g * 8;
        const bf16_t* vB = VT + (size_t)(kvh * 64 + l16) * TT + TL + b * CTXL + 4 * g;
        attn_unit<4, false>(P + (size_t)qrow * kp + kvh * 256 + g * 8, kB, vB, 0, 32, kB, vB, 8, kp, MIX + (size_t)qrow * DM + kvh * 256 + 4 * g, nullptr, 0, dz, 0xffu, gq, g);
    }
}

constexpr int AT_GRP = 1152, AT_VOFF = 8 * AT_GRP, AT_SLOT = 2 * AT_VOFF;
DI void glds16s(const void* sbase, unsigned voff, unsigned lds_dst) { unsigned keep;
    asm volatile("s_mov_b32 %0, m0\n\ts_mov_b32 m0, %3\n\ts_nop 0\n\tglobal_load_lds_dwordx4 %1, %2\n\ts_mov_b32 m0, %0" : "=&s"(keep) : "v"(voff), "s"(sbase), "s"(lds_dst) : "memory"); }
#define LDS_K(sk, keybase, kb, dh) (*(const LAS bf16x8*)((sk) + (((keybase) >> 3) + 2 * (kb)) * AT_GRP + (dh) * 512))
DI bf16x8 lds_v(const LAS unsigned char* sv, int off) {
    const s16x4 lo = *(const LAS s16x4*)(sv + off), hi = *(const LAS s16x4*)(sv + off + 256);
    return (bf16x8){lo[0], lo[1], lo[2], lo[3], hi[0], hi[1], hi[2], hi[3]};
}
#define LDS_V(sv, db, cb) lds_v((sv), 2 * (db) * AT_GRP + (cb) * 128)
#define AT_WAIT_BAR(N) asm volatile("s_waitcnt vmcnt(" #N ") lgkmcnt(0)\n\ts_barrier" ::: "memory")
template <bool BIAS>
DI void attn_head(f32x4 (&o)[4], float mref, float& ls, bf16x8 q0, bf16x8 q1, bf16x8 k00, bf16x8 k01, bf16x8 k10, bf16x8 k11,
                  bf16x8 v0, bf16x8 v1, bf16x8 v2, bf16x8 v3, f32x4 b0, f32x4 b1, unsigned vm) {
    const f32x4 z = {0.f, 0.f, 0.f, 0.f};
    constexpr float C = 0.125f * LOG2E;
    __builtin_amdgcn_s_setprio(1);
    f32x4 s0 = MFMA16(k00, q0, z); f32x4 s1 = MFMA16(k10, q0, z); s0 = MFMA16(k01, q1, s0); s1 = MFMA16(k11, q1, s1);
    __builtin_amdgcn_s_setprio(0);
    f32x4 p0, p1;
#pragma unroll
    for (int e = 0; e < 4; ++e) {
        if (BIAS) { p0[e] = __builtin_amdgcn_exp2f(__builtin_fmaf(s0[e], C, b0[e] - mref)); p1[e] = __builtin_amdgcn_exp2f(__builtin_fmaf(s1[e], C, b1[e] - mref));
                    if (!((vm >> e) & 1u)) p0[e] = 0.f; if (!((vm >> (4 + e)) & 1u)) p1[e] = 0.f; }
        else { p0[e] = __builtin_amdgcn_exp2f(__builtin_fmaf(s0[e], C, -mref)); p1[e] = __builtin_amdgcn_exp2f(__builtin_fmaf(s1[e], C, -mref)); } }
    ls += ((p0[0] + p0[1]) + (p0[2] + p0[3])) + ((p1[0] + p1[1]) + (p1[2] + p1[3]));
    u32x4 pw; pw.x = pk2(p0[0], p0[1]); pw.y = pk2(p0[2], p0[3]); pw.z = pk2(p1[0], p1[1]); pw.w = pk2(p1[2], p1[3]);
    const bf16x8 pb = __builtin_bit_cast(bf16x8, pw);
    __builtin_amdgcn_s_setprio(1);
    o[0] = MFMA16(v0, pb, o[0]); o[1] = MFMA16(v1, pb, o[1]); o[2] = MFMA16(v2, pb, o[2]); o[3] = MFMA16(v3, pb, o[3]);
    __builtin_amdgcn_s_setprio(0);
}
DI void attn_group4(f32x4 (&o)[4][4], const float (&mref)[4], float (&ls)[4], const bf16x8 (&q)[4][2], bf16x8 k00, bf16x8 k01, bf16x8 k10, bf16x8 k11,
                    bf16x8 v0, bf16x8 v1, bf16x8 v2, bf16x8 v3) {
    const f32x4 z = {0.f, 0.f, 0.f, 0.f};
    constexpr float C = 0.125f * LOG2E;
    f32x4 s0[4], s1[4];
    __builtin_amdgcn_s_setprio(1);
#pragma unroll
    for (int h = 0; h < 4; ++h) { s0[h] = MFMA16(k00, q[h][0], z); s1[h] = MFMA16(k10, q[h][0], z); }
#pragma unroll
    for (int h = 0; h < 4; ++h) { s0[h] = MFMA16(k01, q[h][1], s0[h]); s1[h] = MFMA16(k11, q[h][1], s1[h]); }
    __builtin_amdgcn_s_setprio(0);
    bf16x8 pb[4];
#pragma unroll
    for (int h = 0; h < 4; ++h) {
        f32x4 p0, p1;
#pragma unroll
        for (int e = 0; e < 4; ++e) { p0[e] = __builtin_amdgcn_exp2f(__builtin_fmaf(s0[h][e], C, -mref[h])); p1[e] = __builtin_amdgcn_exp2f(__builtin_fmaf(s1[h][e], C, -mref[h])); }
        ls[h] += ((p0[0] + p0[1]) + (p0[2] + p0[3])) + ((p1[0] + p1[1]) + (p1[2] + p1[3]));
        u32x4 pw; pw.x = pk2(p0[0], p0[1]); pw.y = pk2(p0[2], p0[3]); pw.z = pk2(p1[0], p1[1]); pw.w = pk2(p1[2], p1[3]);
        pb[h] = __builtin_bit_cast(bf16x8, pw);
    }
    __builtin_amdgcn_s_setprio(1);
#pragma unroll
    for (int h = 0; h < 4; ++h) { o[h][0] = MFMA16(v0, pb[h], o[h][0]); o[h][1] = MFMA16(v1, pb[h], o[h][1]); o[h][2] = MFMA16(v2, pb[h], o[h][2]); o[h][3] = MFMA16(v3, pb[h], o[h][3]); }
    __builtin_amdgcn_s_setprio(0);
}
DI float q_norm(bf16x8 q0, bf16x8 q1) {
    float ss = 0.f;
#pragma unroll
    for (int e = 0; e < 8; ++e) { const float a = bf2f(q0[e]), b = bf2f(q1[e]); ss += a * a + b * b; }
    ss += __shfl_xor(ss, 16); ss += __shfl_xor(ss, 32);
    return sqrtf(ss);
}
DI float wave_max(float v) {
#pragma unroll
    for (int o = 1; o < 64; o <<= 1) v = fmaxf(v, __shfl_xor(v, o));
    return v;
}
DI void attn_store(bf16_t* op, const f32x4 (&o)[4], float ls) {
    float l = ls; l += __shfl_xor(l, 16); l += __shfl_xor(l, 32);
    const float inv = 1.0f / l;
#pragma unroll
    for (int d = 0; d < 4; ++d) { const f32x4 v = o[d] * inv; u32x2 w; w.x = pk2(v[0], v[1]); w.y = pk2(v[2], v[3]); *(u32x2*)(op + d * 16) = w; }
}

DI void attn_odd_lds(Frame& F, const float* gk  , const float* gq  , bool with_ctx) {
    const bf16_t* P = WSP(bf16_t, WS_BIG); const bf16_t* VT = WSP(bf16_t, WS_VT); bf16_t* MIX = WSP(bf16_t, WS_H);
    const int l16 = F.lane & 15, g = F.lane >> 4;
    const size_t kp = LDP_O;
    const unsigned lds0 = (unsigned)(uintptr_t)F.lds;
    const int drow = F.wave * 8 + (F.lane & 7), dsw = (F.lane >> 3) * 8;
    const unsigned koff = (unsigned)(drow * (int)kp + dsw) * 2u, voff = (unsigned)(drow * TT + dsw) * 2u;
    const unsigned wofs = (unsigned)F.wave * AT_GRP;
    const float kn = 8.0f * 1.01f * wave_max(fabsf(gk[F.lane])) * (0.125f * LOG2E);
    const int bk = (l16 >> 3) * AT_GRP + (l16 & 7) * 16 + g * 128, bv = AT_VOFF + (l16 >> 3) * AT_GRP + (l16 & 7) * 16 + (g >> 1) * 128 + (g & 1) * 8;
    __syncthreads();
    for (int item = F.vcu; item < NB * 2 * 32 + (with_ctx ? NB * 2 * 2 : 0); item += F.G) {
        const bool isc = item >= NB * 2 * 32; const int ci = item - NB * 2 * 32;
        const int b = isc ? (ci >> 2) : (item >> 6), kvh = isc ? ((ci >> 1) & 1) : ((item >> 5) & 1);
        const int tq = isc ? (ci & 1) * 128 : (item & 31) * 128;
        const int qbase = (isc ? TL + b * CTXL : b * SEQ) + tq + F.wave * 16;
        const int nlat = isc ? 0 : 64;
        const int qrow = qbase + l16;
        const bf16_t* qp = P + (size_t)qrow * kp + kvh * 256 + g * 8;
        bf16x8 q[4][2]; f32x4 o[4][4]; float mx[4], ls[4];
#pragma unroll
        for (int h = 0; h < 4; ++h) { q[h][0] = *(const bf16x8*)(qp + h * 64); q[h][1] = *(const bf16x8*)(qp + h * 64 + 32); { int gl_ = g; asm volatile("" : "+v"(gl_)); if (isc) q_prep<false>(q[h][0], q[h][1], gq, gl_, nullptr, 0); else q_prep<true>(q[h][0], q[h][1], gq, gl_, WSP(float, WS_ROPE), tq + F.wave * 16 + l16); } mx[h] = q_norm(q[h][0], q[h][1]) * kn; ls[h] = 0.f;
#pragma unroll
            for (int d = 0; d < 4; ++d) o[h][d] = (f32x4){0.f, 0.f, 0.f, 0.f}; }
        const bf16_t* Kl = P + (size_t)(b * SEQ) * kp + 512 + kvh * 64; const bf16_t* Vl = VT + (size_t)(kvh * 64) * TT + b * SEQ;
        const bf16_t* Kc = P + (size_t)(TL + b * CTXL) * kp + 512 + kvh * 64; const bf16_t* Vc = VT + (size_t)(kvh * 64) * TT + TL + b * CTXL;
        const int n = nlat + 4;
#define AT_ISSUE(s) do { const int s_ = (s); const bf16_t* kt_ = s_ < nlat ? Kl + (size_t)s_ * 64 * kp : Kc + (size_t)(s_ - nlat) * 64 * kp; const bf16_t* vt_ = s_ < nlat ? Vl + s_ * 64 : Vc + (s_ - nlat) * 64; \
        const unsigned sb_ = (unsigned)__builtin_amdgcn_readfirstlane(lds0 + (unsigned)(s_ & 3) * AT_SLOT + wofs); glds16s(kt_, koff, sb_); glds16s(vt_, voff, sb_ + (unsigned)AT_VOFF); } while (0)
        AT_ISSUE(0); AT_ISSUE(1); AT_ISSUE(2);
#pragma unroll 1
        for (int s = 0; s < n; ++s) {
            if (s + 2 < n) AT_WAIT_BAR(4); else if (s + 1 < n) AT_WAIT_BAR(2); else AT_WAIT_BAR(0);
            if (s + 3 < n) AT_ISSUE(s + 3);
            const LAS unsigned char* sk = F.lds + (s & 3) * AT_SLOT + bk; const LAS unsigned char* sv = F.lds + (s & 3) * AT_SLOT + bv;
#pragma unroll
            for (int hf = 0; hf < 2; ++hf) {
                const bf16x8 k00 = LDS_K(sk, hf * 32, 0, 0), k01 = LDS_K(sk, hf * 32, 0, 1), k10 = LDS_K(sk, hf * 32, 1, 0), k11 = LDS_K(sk, hf * 32, 1, 1);
                const bf16x8 v0 = LDS_V(sv, 0, hf * 4), v1 = LDS_V(sv, 1, hf * 4), v2 = LDS_V(sv, 2, hf * 4), v3 = LDS_V(sv, 3, hf * 4);
                attn_group4(o, mx, ls, q, k00, k01, k10, k11, v0, v1, v2, v3);
            }
        }
#undef AT_ISSUE
        AT_WAIT_BAR(0);
        { int ln_ = F.lane; asm volatile("" : "+v"(ln_));
          bf16_t* op = MIX + (size_t)(qbase + (ln_ & 15)) * DM + kvh * 256 + 4 * (ln_ >> 4);
#pragma unroll
          for (int h = 0; h < 4; ++h) attn_store(op + h * 64, o[h], ls[h]); }
    }
}

DI void attn_evenctx_lds(Frame& F, const float* gk  , const float* gq  ) {
    const bf16_t* P = WSP(bf16_t, WS_BIG); const bf16_t* VT = WSP(bf16_t, WS_VT); bf16_t* MIX = WSP(bf16_t, WS_H);
    const int l16 = F.lane & 15, g = F.lane >> 4;
    const size_t kp = LDP_E;
    const unsigned lds0 = (unsigned)(uintptr_t)F.lds;
    const int drow = F.wave * 8 + (F.lane & 7), dsw = (F.lane >> 3) * 8;
    const unsigned koff = (unsigned)(drow * (int)kp + dsw) * 2u, voff = (unsigned)(drow * TT + dsw) * 2u;
    const unsigned wofs = (unsigned)F.wave * AT_GRP;
    const float kn = 8.0f * 1.01f * wave_max(fabsf(gk[F.lane])) * (0.125f * LOG2E);
    const int bk = (l16 >> 3) * AT_GRP + (l16 & 7) * 16 + g * 128, bv = AT_VOFF + (l16 >> 3) * AT_GRP + (l16 & 7) * 16 + (g >> 1) * 128 + (g & 1) * 8;
    __syncthreads();
    for (int item = F.vcu; item < NB * 12; item += F.G) {
        const int b = item / 12, h = item % 12;
        const bool act = F.wave < 4;
        const int qbase = TL + b * CTXL + (F.wave & 3) * 64;
        const int nlat = 0;
        const int qrow = qbase + l16;
        const bf16_t* qp = P + (size_t)qrow * kp + h * 64 + g * 8;
        bf16x8 q[4][2]; f32x4 o[4][4]; float mx[4], ls[4];
#pragma unroll
        for (int h = 0; h < 4; ++h) { q[h][0] = *(const bf16x8*)(qp + (size_t)(16 * h) * kp); q[h][1] = *(const bf16x8*)(qp + (size_t)(16 * h) * kp + 32); { int gl_ = g; asm volatile("" : "+v"(gl_)); q_prep<false>(q[h][0], q[h][1], gq, gl_, nullptr, 0); } mx[h] = q_norm(q[h][0], q[h][1]) * kn; ls[h] = 0.f;
#pragma unroll
            for (int d = 0; d < 4; ++d) o[h][d] = (f32x4){0.f, 0.f, 0.f, 0.f}; }
        const bf16_t* Kl = nullptr; const bf16_t* Vl = nullptr;
        const bf16_t* Kc = P + (size_t)(TL + b * CTXL) * kp + 768 + h * 64; const bf16_t* Vc = VT + (size_t)(h * 64) * TT + TL + b * CTXL;
        const int n = nlat + 4;
#define AT_ISSUE(s) do { const int s_ = (s); const bf16_t* kt_ = s_ < nlat ? Kl + (size_t)s_ * 64 * kp : Kc + (size_t)(s_ - nlat) * 64 * kp; const bf16_t* vt_ = s_ < nlat ? Vl + s_ * 64 : Vc + (s_ - nlat) * 64; \
        const unsigned sb_ = (unsigned)__builtin_amdgcn_readfirstlane(lds0 + (unsigned)(s_ & 3) * AT_SLOT + wofs); glds16s(kt_, koff, sb_); glds16s(vt_, voff, sb_ + (unsigned)AT_VOFF); } while (0)
        AT_ISSUE(0); AT_ISSUE(1); AT_ISSUE(2);
#pragma unroll 1
        for (int s = 0; s < n; ++s) {
            if (s + 2 < n) AT_WAIT_BAR(4); else if (s + 1 < n) AT_WAIT_BAR(2); else AT_WAIT_BAR(0);
            if (s + 3 < n) AT_ISSUE(s + 3);
            const LAS unsigned char* sk = F.lds + (s & 3) * AT_SLOT + bk; const LAS unsigned char* sv = F.lds + (s & 3) * AT_SLOT + bv;
            if (act)
#pragma unroll
            for (int hf = 0; hf < 2; ++hf) {
                const bf16x8 k00 = LDS_K(sk, hf * 32, 0, 0), k01 = LDS_K(sk, hf * 32, 0, 1), k10 = LDS_K(sk, hf * 32, 1, 0), k11 = LDS_K(sk, hf * 32, 1, 1);
                const bf16x8 v0 = LDS_V(sv, 0, hf * 4), v1 = LDS_V(sv, 1, hf * 4), v2 = LDS_V(sv, 2, hf * 4), v3 = LDS_V(sv, 3, hf * 4);
                attn_group4(o, mx, ls, q, k00, k01, k10, k11, v0, v1, v2, v3);
            }
        }
#undef AT_ISSUE
        AT_WAIT_BAR(0);
        { int ln_ = F.lane; asm volatile("" : "+v"(ln_));
          bf16_t* op = MIX + (size_t)(qbase + (ln_ & 15)) * DM + h * 64 + 4 * (ln_ >> 4);
          if (act) {
#pragma unroll
          for (int i = 0; i < 4; ++i) attn_store(op + (size_t)(16 * i) * DM, o[i], ls[i]); } }
    }
}

DI void attn_even_lds(Frame& F, const float* rpb  , const float* gk  , const float* gq  ) {
    const bf16_t* P = WSP(bf16_t, WS_BIG); const bf16_t* VT = WSP(bf16_t, WS_VT); bf16_t* MIX = WSP(bf16_t, WS_H);
    const int l16 = F.lane & 15, g = F.lane >> 4;
    const size_t kp = LDP_E;
    const unsigned lds0 = (unsigned)(uintptr_t)F.lds;
    LAS float* blall = (LAS float*)(F.lds + 4 * AT_SLOT);
    const int drow = F.wave * 8 + (F.lane & 7), dsw = (F.lane >> 3) * 8;
    const unsigned koff = (unsigned)(drow * (int)kp + dsw) * 2u, voff = (unsigned)(drow * TT + dsw) * 2u;
    const unsigned wofs = (unsigned)F.wave * AT_GRP;
    const float kn = 8.0f * 1.01f * wave_max(fabsf(gk[F.lane])) * (0.125f * LOG2E);
    const int bk = (l16 >> 3) * AT_GRP + (l16 & 7) * 16 + g * 128, bv = AT_VOFF + (l16 >> 3) * AT_GRP + (l16 & 7) * 16 + (g >> 1) * 128 + (g & 1) * 8;
    LAS u32x4* dct = (LAS u32x4*)(F.lds + 4 * AT_SLOT + 22528);
    float bmx = 0.f;
    for (int i = F.tid; i < 12 * 465; i += 512) { const float bv_ = rpb[i] * LOG2E; blall[i] = bv_; bmx = fmaxf(bmx, fabsf(bv_)); }
    LAS float* wm = (LAS float*)(F.lds + 4 * AT_SLOT + 22528 + 4096);
    bmx = wave_max(bmx); if (F.lane == 0) wm[F.wave] = bmx;
    if (F.wave == 0) {
#pragma unroll
        for (int j = 0; j < 4; ++j) {
            const int qc = 16 * j + l16, kcol0 = j == 0 ? 0 : (j == 1 ? 8 : (j == 2 ? 24 : 32)), cs = qc < 8 ? 0 : (qc > 56 ? 48 : qc - 8);
            unsigned a = 0u, bb = 0u, vm = 0u;
#pragma unroll
            for (int e = 0; e < 8; ++e) { const int kc = kcol0 + (e < 4 ? 4 * g + e : 16 + 4 * g + (e - 4));
                if (kc >= cs && kc < cs + 16) vm |= 1u << e;
                int d = kc - qc + 15; d = d < 0 ? 0 : (d > 30 ? 30 : d);
                if (e < 4) a |= (unsigned)d << (8 * e); else bb |= (unsigned)d << (8 * (e - 4)); }
            dct[j * 64 + F.lane] = (u32x4){a, bb, vm, 0u};
        }
    }
    __syncthreads();
    const float bmax = fmaxf(fmaxf(fmaxf(wm[0], wm[1]), fmaxf(wm[2], wm[3])), fmaxf(fmaxf(wm[4], wm[5]), fmaxf(wm[6], wm[7])));
    for (int item = F.vcu; item < NB * 12 * 8; item += F.G) {
        const int b = item / 96, rem = item % 96, h = rem >> 3, rg = rem & 7, r = rg * 8 + F.wave;
        const int r0 = r < 4 ? 0 : (r > 60 ? 56 : r - 4);
        const int rlo = rg == 0 ? 0 : rg * 8 - 4, rhi = (rg == 7 ? 56 : rg * 8 + 3) + 7;
        const int nloc = rhi - rlo + 1, n = nloc + 4;
        const LAS float* bl = blall + h * 465;
        bf16x8 q[4][2]; f32x4 o[4][4]; float mx[4], ls[4];
        const int qrow0 = b * SEQ + r * 64 + l16;
#pragma unroll
        for (int j = 0; j < 4; ++j) { const bf16_t* qp = P + (size_t)(qrow0 + 16 * j) * kp + h * 64 + g * 8; q[j][0] = *(const bf16x8*)qp; q[j][1] = *(const bf16x8*)(qp + 32); { int gl_ = g; asm volatile("" : "+v"(gl_)); q_prep<false>(q[j][0], q[j][1], gq, gl_, nullptr, 0); } mx[j] = q_norm(q[j][0], q[j][1]) * kn + bmax; ls[j] = 0.f;
#pragma unroll
            for (int d = 0; d < 4; ++d) o[j][d] = (f32x4){0.f, 0.f, 0.f, 0.f}; }
        const bf16_t* Kl = P + (size_t)(b * SEQ + rlo * 64) * kp + 768 + h * 64; const bf16_t* Vl = VT + (size_t)(h * 64) * TT + b * SEQ + rlo * 64;
        const bf16_t* Kc = P + (size_t)(TL + b * CTXL) * kp + 768 + h * 64; const bf16_t* Vc = VT + (size_t)(h * 64) * TT + TL + b * CTXL;
#define AT_ISSUE(s) do { const int s_ = (s); const bf16_t* kt_ = s_ < nloc ? Kl + (size_t)s_ * 64 * kp : Kc + (size_t)(s_ - nloc) * 64 * kp; const bf16_t* vt_ = s_ < nloc ? Vl + s_ * 64 : Vc + (s_ - nloc) * 64; \
        const unsigned sb_ = (unsigned)__builtin_amdgcn_readfirstlane(lds0 + (unsigned)(s_ & 3) * AT_SLOT + wofs); glds16s(kt_, koff, sb_); glds16s(vt_, voff, sb_ + (unsigned)AT_VOFF); } while (0)
        AT_ISSUE(0); AT_ISSUE(1); AT_ISSUE(2);
#pragma unroll 1
        for (int s = 0; s < n; ++s) {
            if (s + 2 < n) AT_WAIT_BAR(4); else if (s + 1 < n) AT_WAIT_BAR(2); else AT_WAIT_BAR(0);
            if (s + 3 < n) AT_ISSUE(s + 3);
            const LAS unsigned char* sk = F.lds + (s & 3) * AT_SLOT + bk; const LAS unsigned char* sv = F.lds + (s & 3) * AT_SLOT + bv;
            if (s < nloc) {
                const int kr = rlo + s;
                if (kr >= r0 && kr < r0 + 8) {
                    const LAS float* rp = bl + (kr - r + 7) * 31;
#pragma unroll
                    for (int j = 0; j < 4; ++j) {
                        const int kc0 = j == 0 ? 0 : (j == 1 ? 8 : (j == 2 ? 24 : 32));
                        const bf16x8 k00 = LDS_K(sk, kc0, 0, 0), k01 = LDS_K(sk, kc0, 0, 1), k10 = LDS_K(sk, kc0, 1, 0), k11 = LDS_K(sk, kc0, 1, 1);
                        const bf16x8 v0 = LDS_V(sv, 0, kc0 >> 3), v1 = LDS_V(sv, 1, kc0 >> 3), v2 = LDS_V(sv, 2, kc0 >> 3), v3 = LDS_V(sv, 3, kc0 >> 3);
                        f32x4 b0, b1; const u32x4 dt_ = dct[j * 64 + F.lane]; unsigned da_ = dt_.x, db_ = dt_.y;
#pragma unroll
                        for (int e = 0; e < 4; ++e) { b0[e] = rp[(da_ >> (8 * e)) & 255u]; b1[e] = rp[(db_ >> (8 * e)) & 255u]; }
                        attn_head<true>(o[j], mx[j], ls[j], q[j][0], q[j][1], k00, k01, k10, k11, v0, v1, v2, v3, b0, b1, dt_.z);
                        __builtin_amdgcn_sched_barrier(0);
                    }
                }
            } else {
#pragma unroll
                for (int hf = 0; hf < 2; ++hf) {
                    const bf16x8 k00 = LDS_K(sk, hf * 32, 0, 0), k01 = LDS_K(sk, hf * 32, 0, 1), k10 = LDS_K(sk, hf * 32, 1, 0), k11 = LDS_K(sk, hf * 32, 1, 1);
                    const bf16x8 v0 = LDS_V(sv, 0, hf * 4), v1 = LDS_V(sv, 1, hf * 4), v2 = LDS_V(sv, 2, hf * 4), v3 = LDS_V(sv, 3, hf * 4);
                    attn_group4(o, mx, ls, q, k00, k01, k10, k11, v0, v1, v2, v3);
                    __builtin_amdgcn_sched_barrier(0);
                }
            }
        }
#undef AT_ISSUE
        AT_WAIT_BAR(0);
        { int ln_ = F.lane; asm volatile("" : "+v"(ln_));
          bf16_t* op = MIX + (size_t)(b * SEQ + r * 64 + (ln_ & 15)) * DM + h * 64 + 4 * (ln_ >> 4);
#pragma unroll
          for (int j = 0; j < 4; ++j) attn_store(op + (size_t)(16 * j) * DM, o[j], ls[j]); }
    }
}

DI void sgu_phase(Frame& F, const Args& AR, int io) {
    const bf16_t* P = WSP(bf16_t, WS_BIG); bf16_t* MIX = WSP(bf16_t, WS_H);
    const bf16_t* WSB = WSP(bf16_t, WS_WSB) + (size_t)io * 4 * 128 * 128;
    const float* vg = in_ptr(AR, 16) + io * 512; const float* bs = in_ptr(AR, 18) + io * 512;
    LAS bf16_t* VT = (LAS bf16_t*)F.lds;
    __syncthreads();
    const int l16 = F.lane & 15, g4 = F.lane >> 4;
    const int j = F.tid >> 2, qd = F.tid & 3;
    constexpr int NU = (TT / 128) * 4;
    bf16x8 raw[4];
    if (F.vcu < NU) { const bf16_t* src = P + (size_t)((F.vcu >> 2) * 128 + j) * LDP_O + 1280 + (F.vcu & 3) * 128 + qd * 32;
#pragma unroll
        for (int i = 0; i < 4; ++i) raw[i] = *(const bf16x8*)(src + 8 * i); }
    for (int unit = F.vcu; unit < NU; unit += F.G) {
        const int chunk = unit >> 2, grp = unit & 3, row0 = chunk * 128;
        {
            float v[32]; float ss = 0.f;
#pragma unroll
            for (int i = 0; i < 4; ++i) {
#pragma unroll
                for (int e = 0; e < 8; ++e) { const float x = gelu_f(bf2f(raw[i][e])); v[8 * i + e] = x; ss += x * x; } }
            ss += __shfl_xor(ss, 1); ss += __shfl_xor(ss, 2);
            const float rstd = rsqrtf(ss * (1.0f / 128.0f) + EPS);
#pragma unroll
            for (int e = 0; e < 32; ++e) { const int c = qd * 32 + e; VT[c * 136 + j] = (bf16_t)(pk2(v[e] * rstd * vg[grp * 128 + c], 0.f) & 0xffffu); }
        }
        __syncthreads();
        const int nu = unit + F.G;
        if (nu < NU) { const bf16_t* src = P + (size_t)((nu >> 2) * 128 + j) * LDP_O + 1280 + (nu & 3) * 128 + qd * 32;
#pragma unroll
            for (int i = 0; i < 4; ++i) raw[i] = *(const bf16x8*)(src + 8 * i); }
        f32x4 acc[8];
#pragma unroll
        for (int cb = 0; cb < 8; ++cb) acc[cb] = (f32x4){0.f, 0.f, 0.f, 0.f};
        const int ti = F.wave * 16 + l16;
        const bf16_t* wp = WSB + (size_t)grp * 128 * 128 + (size_t)ti * 128 + 8 * g4;
        const bf16_t* up = P + (size_t)(row0 + ti) * LDP_O + 768 + grp * 128 + 4 * g4;
        bf16x8 bw[4]; s16x4 ur[8];
#pragma unroll
        for (int ks = 0; ks < 4; ++ks) bw[ks] = *(const bf16x8*)(wp + 32 * ks);
#pragma unroll
        for (int cb = 0; cb < 8; ++cb) ur[cb] = *(const s16x4*)(up + 16 * cb);
        const float bias = bs[grp * 128 + ti];
#pragma unroll
        for (int ks = 0; ks < 4; ++ks) {
#pragma unroll
            for (int cb = 0; cb < 8; ++cb) { const bf16x8 av = *(const LAS bf16x8*)(VT + (16 * cb + l16) * 136 + 32 * ks + 8 * g4); acc[cb] = MFMA16(av, bw[ks], acc[cb]); }
        }
        bf16_t* op = MIX + (size_t)(row0 + ti) * DM + 512 + grp * 128 + 4 * g4;
#pragma unroll
        for (int cb = 0; cb < 8; ++cb) { u32x2 w;
            w.x = pk2(gelu_f(bf2f(ur[cb][0])) * (acc[cb][0] + bias), gelu_f(bf2f(ur[cb][1])) * (acc[cb][1] + bias));
            w.y = pk2(gelu_f(bf2f(ur[cb][2])) * (acc[cb][2] + bias), gelu_f(bf2f(ur[cb][3])) * (acc[cb][3] + bias));
            *(u32x2*)(op + 16 * cb) = w; }
        __syncthreads();
    }
}

#ifndef PM
#define PM 0xffff
#endif
#ifndef REP
#define REP 0
#endif
DI void grid_barrier(unsigned* cnt, unsigned target) {
    asm volatile("s_waitcnt vmcnt(0) lgkmcnt(0)" ::: "memory");
    __syncthreads();
    if (threadIdx.x == 0) {
        __builtin_amdgcn_fence(__ATOMIC_RELEASE, "agent");
        asm volatile("s_waitcnt vmcnt(0)" ::: "memory");
        __hip_atomic_fetch_add(cnt, 1u, __ATOMIC_RELAXED, __HIP_MEMORY_SCOPE_AGENT);
        while (__hip_atomic_load(cnt, __ATOMIC_RELAXED, __HIP_MEMORY_SCOPE_AGENT) < target) __builtin_amdgcn_s_sleep(2);
        __builtin_amdgcn_fence(__ATOMIC_ACQUIRE, "agent");
        asm volatile("s_waitcnt vmcnt(0)" ::: "memory");
    }
    __syncthreads();
}
#define GRID_SYNC() do { nbar += (unsigned)gridDim.x; grid_barrier(barw, nbar); } while (0)
__global__ void __launch_bounds__(512, 2) fwd_megakernel(Args args) {
    extern __shared__ __attribute__((aligned(16))) unsigned char lds_raw[];
    cg::grid_group grid = cg::this_grid();
    Frame F;
    F.lds = (LAS unsigned char*)lds_raw;
    F.tid = threadIdx.x; F.lane = F.tid & 63; F.wave = __builtin_amdgcn_readfirstlane(F.tid >> 6);
    F.G = gridDim.x; { const int bx = blockIdx.x; F.vcu = (F.G % 8 == 0) ? (bx % 8) * (F.G / 8) + bx / 8 : bx; }
    F.out = GLOBAL_PTR(float, args.out); F.ws = GLOBAL_PTR(unsigned char, args.ws);
    int bx = blockIdx.x;

    const Args& AR = args;
    unsigned* barw = GLOBAL_PTR(unsigned, args.ws); unsigned nbar = 0u;
    grid.sync();
    if (PM & 1) prologue_a(F, AR, 5, 6);
    GRID_SYNC();
    if (PM & 2) prologue_b(F, AR);
    GRID_SYNC();
#pragma unroll 1
    for (int k_ = 0; k_ < 2; ++k_) {
        if ((k_ == 0) == ((blockIdx.x & 1) != 0)) norm_phase(F, in_ptr(AR, 0), in_ptr(AR, 2), in_ptr(AR, 4), WSP(float, WS_MOD), 0);
        else prologue_a(F, AR, 0, 5);
    }
    GRID_SYNC();

    enum { T_NOP = 0, T_NORM, T_SWI, T_RES, T_STORE, T_FT, T_POST, T_SGU, T_ATTE, T_ATTO };
#pragma unroll 1
    for (int l = 0; l < 4; ++l) {
        const bool even = (l & 1) == 0; const int li = l >> 1;
#pragma unroll 1
        for (int op = 0; op < 14; ++op) {
            { int t_ = threadIdx.x; asm volatile("" : "+v"(t_)); F.tid = t_; F.lane = t_ & 63; F.wave = __builtin_amdgcn_readfirstlane(t_ >> 6);
              unsigned char* w_ = args.ws; asm volatile("" : "+s"(w_)); F.ws = GLOBAL_PTR(unsigned char, w_); float* o_ = args.out; asm volatile("" : "+s"(o_)); F.out = GLOBAL_PTR(float, o_);
              int g_ = gridDim.x, b_ = blockIdx.x; asm volatile("" : "+s"(g_), "+s"(b_)); F.G = g_; bx = b_; F.vcu = (g_ % 8 == 0) ? (b_ % 8) * (g_ / 8) + b_ / 8 : b_; }
            bf16_t* H = WSP(bf16_t, WS_H); bf16_t* BIG = WSP(bf16_t, WS_BIG); float* XC = WSP(float, WS_XC);
            const float* modl = WSP(float, WS_MOD) + (size_t)l * NBI * MODW;
            const int opq = ((op == 6 || op == 7) && (bx & 1)) ? 13 - op : op;
            int type = T_NOP;
            const bool skip0 = (l == 0 && op == 0);
            if (op == 0 || op == 3 || op == 11) type = skip0 ? T_NOP : T_NORM;
            else if (op == 1 || op == 12) type = T_SWI;
            else if (op == 2 || op == 10 || op == 13) type = T_RES;
            else if (op == 4) type = T_STORE;
            else if (op == 5) type = even ? T_FT : T_NOP;
            else if (opq == 6) type = T_POST;
            else if (opq == 7) type = even ? T_STORE : T_SGU;
            else if (op == 8) type = even ? T_STORE : T_NOP;
            else if (op == 9) type = even ? T_ATTE : T_ATTO;
            const bool first = (l == 0 && op <= 2);
            const int nMt = (l == 3 && op >= 10) ? TL / 256 : TT / 256;
            const float* srcL = first ? in_ptr(AR, 0) : F.out; const float* srcC = first ? in_ptr(AR, 2) : XC;
            if (type == T_NORM) {
                const int sub = op == 0 ? 0 : (op == 3 ? 1 : 2);
                if (even && op == 3) norm_pair_phase(F, srcL, srcC, in_ptr(AR, 4) + (size_t)(l * 3 + sub) * DM, modl, sub);
                else norm_phase(F, srcL, srcC, in_ptr(AR, 4) + (size_t)(l * 3 + sub) * DM, modl, sub);
            } else if (type == T_SWI) {
                const int fi = l * 2 + (op == 1 ? 0 : 1);
                pg8::Gemm g{H, WSP(bf16_t, WS_WGU) + (size_t)fi * 2 * DFF * DM, DM, DM, DM, 0, 0}; pg8::Order S; S.init(nMt, 2 * DFF / 256, 1, F.G, bx);
                pg8::EpiSwiGLU E{BIG};
#pragma unroll 1
                for (int rep_ = 0; rep_ < ((REP & 4) ? 2 : 1); ++rep_) pg8::gemm_phase(F.lds, F.tid, g, S, E);
            } else if (type == T_RES) {
                pg8::Gemm g; pg8::EpiResid E; E.srcL = srcL; E.srcC = srcC; E.dstL = F.out; E.dstC = XC;
                if (op == 10) { g = pg8::Gemm{H, WSP(bf16_t, WS_WOUT) + (size_t)l * DM * DM, DM, DM, DM, 0, 0}; E.gate = modl + 1 * 3072 + 2048; E.coef = 1.0f; }
                else { const int fi = l * 2 + (op == 2 ? 0 : 1), sub = op == 2 ? 0 : 2; g = pg8::Gemm{BIG, WSP(bf16_t, WS_WD) + (size_t)fi * DM * DFF, DFF, DFF, DFF, 0, 0}; E.gate = modl + sub * 3072 + 2048; E.coef = 0.5f; }
                pg8::Order S; S.init(nMt, DM / 256, 1, F.G, bx);
                if (PM & 16) pg8::gemm_phase(F.lds, F.tid, g, S, E);
            } else if (type == T_STORE) {
                pg8::Gemm g; pg8::EpiStore E; pg8::Order S;
                if (op == 4) {
                    const bf16_t* W = even ? WSP(bf16_t, WS_WINAB) + (size_t)li * 2816 * DM : WSP(bf16_t, WS_WINCD) + (size_t)li * 1792 * DM;
                    const int ldp = even ? LDP_E : LDP_O;
                    g = pg8::Gemm{H, W, DM, DM, DM, 0, 0}; S.init(TT / 256, ldp / 256, 1, F.G, bx); E = pg8::EpiStore{BIG, ldp, 0, 1.0f};
                } else if (opq == 7) {
                    g = pg8::Gemm{WSP(bf16_t, WS_DFT), WSP(bf16_t, WS_FT), 4096, 4096, 4096, 0, (size_t)256 * 4096}; S.init(SEQ / 256, 1, NB, F.G, bx);
                    E = pg8::EpiStore{H + 768, DM, (size_t)SEQ * DM, 1.0f / 512.0f};
                } else {
                    g = pg8::Gemm{WSP(bf16_t, WS_DFTC), WSP(bf16_t, WS_FTC), 512, 512, 512, 0, (size_t)256 * 512}; S.init(1, 1, NB, F.G, bx);
                    E = pg8::EpiStore{H + (size_t)TL * DM + 768, DM, (size_t)CTXL * DM, 1.0f / 128.0f};
                }
                if (PM & 32) pg8::gemm_phase(F.lds, F.tid, g, S, E);
            } else if (type == T_FT) {
                pg8::EpiFT E{WSP(bf16_t, WS_FT), WSP(bf16_t, WS_FTC), WSP(bf16_t, WS_VT)};
#pragma unroll 1
                for (int part = 0; part < 2; ++part) {
                    pg8::Gemm g{WSP(bf16_t, WS_WINAB) + (size_t)li * 2816 * DM + (size_t)1536 * DM, part ? WSP(bf16_t, WS_HS) : H, DM, DM, DM, 0, 0};
                    pg8::Order S; if (part) S.init_fourier(F.G, bx); else S.init(3, TT / 256, 1, F.G, bx, 0);
                    if (PM & 64) pg8::gemm_phase(F.lds, F.tid, g, S, E);
                }
            } else if (type == T_POST) {
                if (PM & 128) postpass(F, even, even ? in_ptr(AR, 11) + li * 128 : in_ptr(AR, 15) + li * 128);
            } else if (type == T_SGU) {
                if (PM & 512) sgu_phase(F, AR, li);
            } else if (type == T_ATTE) {
                if (PM & 1024) { const float* qg_ = in_ptr(AR, 11) + li * 128; attn_even_lds(F, in_ptr(AR, 12) + (size_t)li * 12 * 465, qg_ + 64, qg_); attn_evenctx_lds(F, qg_ + 64, qg_); }
            } else if (type == T_ATTO) {
                if (PM & 2048) { const float* qg_ = in_ptr(AR, 15) + li * 128; attn_odd_lds(F, qg_ + 64, qg_, l < 3); }
            }
            if (!(op == 4 || op == 6 || op == 7 || skip0)) GRID_SYNC();
        }
    }
}

extern "C" void kernel_launch(void* const* d_in, const int* in_sizes, int n_in, void* d_out, int out_size, void* d_ws, size_t ws_size, hipStream_t stream) {
    static int grid = 0;
    if (grid == 0) {
        if (n_in != 19 || out_size != TL * DM || ws_size < WS_END) { fprintf(stderr, "kernel_launch: unexpected shapes (n_in %d out %d ws %zu)\n", n_in, out_size, ws_size); grid = -1; return; }
        int dev = 0, cus = 0, per_cu = 0;
        hipGetDevice(&dev); hipDeviceGetAttribute(&cus, hipDeviceAttributeMultiprocessorCount, dev);
        hipFuncSetAttribute((const void*)fwd_megakernel, hipFuncAttributeMaxDynamicSharedMemorySize, LDS_BYTES);
        hipOccupancyMaxActiveBlocksPerMultiprocessor(&per_cu, (const void*)fwd_megakernel, 512, LDS_BYTES);
        if (per_cu < 1) { fprintf(stderr, "kernel_launch: occupancy query says %d blocks/CU\n", per_cu); per_cu = 1; }
        grid = cus * per_cu;
        (void)hipGetLastError();
    }
    if (grid < 0) return;
    (void)hipMemsetAsync(d_ws, 0, 256, stream);
    Args a{};
    for (int i = 0; i < 19; ++i) a.in[i] = (const float*)d_in[i];
    a.out = (float*)d_out; a.ws = (unsigned char*)d_ws;
    void* kargs[] = {&a};
    hipError_t e = hipLaunchCooperativeKernel((const void*)fwd_megakernel, dim3(grid), dim3(512), kargs, LDS_BYTES, stream);
    if (e != hipSuccess) fprintf(stderr, "cooperative launch failed: %s (grid %d)\n", hipGetErrorString(e), grid);
}
```

```cpp
#include <hip/hip_runtime.h>
#include <hip/hip_cooperative_groups.h>
#include <cstdio>
#include <cstdint>
namespace cg = cooperative_groups;

#define LAS __attribute__((address_space(3)))
#define DI __device__ __forceinline__
typedef unsigned short bf16_t;
typedef short bf16x8 __attribute__((ext_vector_type(8)));
typedef short s16x4 __attribute__((ext_vector_type(4)));
typedef float f32x4 __attribute__((ext_vector_type(4)));
typedef float f32x2 __attribute__((ext_vector_type(2)));
typedef unsigned u32x4 __attribute__((ext_vector_type(4)));
typedef unsigned u32x2 __attribute__((ext_vector_type(2)));
typedef __bf16 bf16x2_t __attribute__((ext_vector_type(2)));

#define LDS_WAIT() asm volatile("s_waitcnt lgkmcnt(0)" ::: "memory")
#define GLOBAL_PTR(T, p) ((T*)(__attribute__((address_space(1))) T*)(launder_u64((unsigned long long)(p))))
__device__ __forceinline__ unsigned long long launder_u64(unsigned long long v) { asm volatile("" : "+s"(v)); return v; }

constexpr int DM = 1024, NB = 16, SEQ = 4096, CTXL = 256, TL = NB * SEQ, TC = NB * CTXL, TT = TL + TC, DFF = 2816;
constexpr int MODW = 9216, NBI = 17;
constexpr int LDP_E = 1536, LDP_O = 1792;
constexpr float EPS = 1e-6f;
constexpr float LOG2E = 1.4426950408889634f;

constexpr size_t MiB = 1u << 20;
constexpr size_t WS_MOD = 1 * MiB;
constexpr size_t WS_ROPE = 4 * MiB;
constexpr size_t WS_MODP = 5 * MiB;
constexpr size_t WS_WSB = 25 * MiB;
constexpr size_t WS_DFTC = 26 * MiB;
constexpr size_t WS_WGU = 27 * MiB;
constexpr size_t WS_WD = 115 * MiB;
constexpr size_t WS_WINAB = 159 * MiB;
constexpr size_t WS_WINCD = 170 * MiB;
constexpr size_t WS_WOUT = 177 * MiB;
constexpr size_t WS_DFT = 185 * MiB;
constexpr size_t WS_XC = 249 * MiB;
constexpr size_t WS_H = 265 * MiB;
constexpr size_t WS_BIG = 401 * MiB;
constexpr size_t WS_VT = 707 * MiB;
constexpr size_t WS_FT = 809 * MiB;
constexpr size_t WS_FTC = 873 * MiB;
constexpr size_t WS_HS = 877 * MiB;
constexpr size_t WS_END = 1013 * MiB;

constexpr int LDS_BYTES = 131072 + 1024;

DI unsigned pk2(float lo, float hi) { f32x2 v = {lo, hi}; bf16x2_t b = __builtin_convertvector(v, bf16x2_t); return __builtin_bit_cast(unsigned, b); }
DI float bf2f(short s) { return __uint_as_float(((unsigned)(unsigned short)s) << 16); }
DI float wave_sum(float v) {
#pragma unroll
    for (int o = 1; o < 64; o <<= 1) v += __shfl_xor(v, o);
    return v;
}
DI float silu_f(float x) { return x * __builtin_amdgcn_rcpf(1.0f + __expf(-x)); }
DI float gelu_f(float x) { const float y = 0.7978845608028654f * (x + 0.044715f * x * x * x); return x * __builtin_amdgcn_rcpf(1.0f + __expf(-2.0f * y)); }

namespace pg8 {
constexpr int BM = 256, BK = 64, HALF = 128, HTB = HALF * BK * 2, STAGE_BYTES = 8 * HTB, NXCD = 8, WGM = 4;
DI int lds_byte(int r, int c) { const int st = (r >> 4) * 2 + (c >> 5), rr = r & 15, cc = c & 31, ob = rr * 64 + cc * 2; return st * 1024 + (ob ^ (((ob >> 9) & 1) << 5)); }
DI void stage_rc(int b, int& R, int& C) { const int st = b / 1024, sb = b % 1024, swz = sb ^ (((sb >> 9) & 1) << 5); R = (st >> 1) * 16 + swz / 64; C = (st & 1) * 32 + (swz % 64) / 2; }
DI int perm32(int rho) { const int n = rho >> 4, i = rho & 15; return 8 * (i >> 2) + 4 * n + (i & 3); }

struct Unit { int pm, pn, pz; };
struct Gemm { const bf16_t* A; const bf16_t* Bt; int lda, ldb, K; size_t zA, zB; };
struct Order {
    int nM, nN, per, nwg, G, c, pm0, fmode;
    DI void init(int nM_, int nN_, int nZ, int G_, int c_, int pm0_ = 0) { nM = nM_; nN = nN_; per = nM_ * nN_; nwg = per * nZ; G = G_; c = c_; pm0 = pm0_; fmode = 0; }
    DI void init_fourier(int G_, int c_) { nM = 2; nN = TT / 256; per = 304; nwg = 304; G = G_; c = c_; pm0 = 3; fmode = 1; }
    DI bool next(int i, Unit& u) const {
        const long L = (long)i * G + c; if (L >= nwg) return false;
        if (fmode) { const int w = (int)L; u.pz = 0;
            if (w < 272) { const int b = w / 17, r = w % 17; if (r < 9) { u.pm = 3; u.pn = b * 16 + r; } else { u.pm = 4; u.pn = b * 16 + r - 1; } }
            else { const int cq = w - 272; u.pm = 3 + (cq & 1); u.pn = TL / 256 + (cq >> 1); }
            return true; }
        int wgid = (int)L; { const int q = nwg / NXCD, r = nwg % NXCD, xcd = wgid % NXCD, off = wgid / NXCD; wgid = (xcd < r ? xcd * (q + 1) : r * (q + 1) + (xcd - r) * q) + off; }
        u.pz = wgid / per; const int w = wgid % per;
        const int nig = WGM * nN, gid = w / nig, fm = gid * WGM, gsz = (nM - fm) < WGM ? (nM - fm) : WGM;
        u.pm = pm0 + fm + ((w % nig) % gsz); u.pn = (w % nig) / gsz; return true;
    }
};
DI const char* a_of(const Gemm& g, const Unit& u) { return (const char*)(g.A + (size_t)u.pz * g.zA + (size_t)u.pm * BM * g.lda); }
DI const char* b_of(const Gemm& g, const Unit& u) { return (const char*)(g.Bt + (size_t)u.pz * g.zB + (size_t)u.pn * BM * g.ldb); }

template <class Epi>
DI void gemm_phase(LAS unsigned char* lds, int tid, const Gemm g, const Order& S, const Epi& E) {
    const int wid = __builtin_amdgcn_readfirstlane(tid >> 6), lane = tid & 63, wr = wid >> 2, wc = wid & 3, fr = lane & 15, fq = lane >> 4;
    const int K = g.K, nt = K / BK;
    unsigned voffA[2], voffB[2];
#pragma unroll
    for (int i = 0; i < 2; ++i) { int R, C; stage_rc(tid * 16 + i * 8192, R, C); const int Rb = (R & ~31) + perm32(R & 31);
        voffA[i] = (unsigned)(R * g.lda + C) * 2u; voffB[i] = (unsigned)(Rb * g.ldb + C) * 2u; }
    const size_t kstep = (size_t)(BK * 2);
    const size_t hstepA = (size_t)HALF * g.lda * 2, hstepB = (size_t)HALF * g.ldb * 2;
    const unsigned ldsw = (unsigned)wid * 1024u;
    const int aoff = lds_byte(wr * 64 + fr, fq * 8), boff = lds_byte(wc * 32 + fr, fq * 8);
#define PG8_SA(b, h) (((b) * 2 + (h)) * HTB)
#define PG8_SB(b, h) ((4 + (b) * 2 + (h)) * HTB)
#define PG8_STAGE(bufoff, gbase, voff) do { _Pragma("unroll") for (int _i = 0; _i < 2; ++_i) \
        __builtin_amdgcn_global_load_lds((const unsigned*)((const char*)(gbase) + (voff)[_i]), (LAS unsigned*)(lds + (bufoff) + ldsw + _i * 8192), 16, 0, 0); } while (0)
#define PG8_LDA(dst, b, h) do { _Pragma("unroll") for (int m = 0; m < 4; ++m) _Pragma("unroll") for (int k = 0; k < 2; ++k) dst[m][k] = *(const LAS bf16x8*)(lds + PG8_SA(b, h) + aoff + m * 2048 + k * 1024); } while (0)
#define PG8_LDB(dst, b, h) do { _Pragma("unroll") for (int n = 0; n < 2; ++n) _Pragma("unroll") for (int k = 0; k < 2; ++k) dst[n][k] = *(const LAS bf16x8*)(lds + PG8_SB(b, h) + boff + n * 2048 + k * 1024); } while (0)
#define PG8_MMA(ai, bj, At, Bt) do { __builtin_amdgcn_s_setprio(1); _Pragma("unroll") for (int m = 0; m < 4; ++m) _Pragma("unroll") for (int n = 0; n < 2; ++n) _Pragma("unroll") for (int k = 0; k < 2; ++k) \
        acc[ai][bj][m][n] = __builtin_amdgcn_mfma_f32_16x16x32_bf16(Bt[n][k], At[m][k], acc[ai][bj][m][n], 0, 0, 0); __builtin_amdgcn_s_setprio(0); } while (0)
#define PG8_WAIT_V(n) asm volatile("s_waitcnt vmcnt(" #n ")" ::: "memory")
#define PG8_WAIT_L(n) asm volatile("s_waitcnt lgkmcnt(" #n ")" ::: "memory")
#define PG8_BAR __builtin_amdgcn_s_barrier()
#define PG8_SCHED __builtin_amdgcn_sched_barrier(0)
    __syncthreads();
    Unit cur, nxt; int ui = 0;
    if (!S.next(0, cur)) return;
    f32x4 acc[2][2][4][2];
#pragma unroll
    for (int a = 0; a < 2; ++a)
#pragma unroll
        for (int b = 0; b < 2; ++b)
#pragma unroll
            for (int m = 0; m < 4; ++m)
#pragma unroll
                for (int n = 0; n < 2; ++n) acc[a][b][m][n] = (f32x4){0.f, 0.f, 0.f, 0.f};
    bf16x8 At[4][2], B0[2][2], B1[2][2];
    const char* cA = a_of(g, cur); const char* cB = b_of(g, cur);
    PG8_STAGE(PG8_SB(0, 0), cB, voffB); PG8_STAGE(PG8_SB(0, 1), cB + hstepB, voffB); PG8_STAGE(PG8_SA(0, 0), cA, voffA); PG8_STAGE(PG8_SA(0, 1), cA + hstepA, voffA);
    if (wr == 1) PG8_BAR;
    PG8_WAIT_V(2); PG8_BAR;
    PG8_STAGE(PG8_SB(1, 0), cB + kstep, voffB); PG8_STAGE(PG8_SA(1, 0), cA + kstep, voffA); PG8_STAGE(PG8_SB(1, 1), cB + hstepB + kstep, voffB);
    PG8_WAIT_V(6); PG8_BAR;
#pragma unroll 1
    for (;;) {
        const bool has_next = S.next(ui + 1, nxt);
        const char* nA = has_next ? a_of(g, nxt) : cA; const char* nB = has_next ? b_of(g, nxt) : cB;
#pragma unroll 1
        for (int t = 0; t < nt; t += 2) {
            const bool last = (t == nt - 2);
            const char* a1 = cA + (size_t)(t + 1) * kstep;
            const char* a2 = last ? nA : cA + (size_t)(t + 2) * kstep; const char* b2 = last ? nB : cB + (size_t)(t + 2) * kstep;
            const char* a3 = a2 + kstep; const char* b3 = b2 + kstep;
            PG8_LDB(B0, 0, 0); PG8_LDB(B1, 0, 1); PG8_SCHED; PG8_LDA(At, 0, 0); PG8_STAGE(PG8_SA(1, 1), a1 + hstepA, voffA);
            PG8_WAIT_V(8); PG8_WAIT_L(0); PG8_BAR; PG8_MMA(0, 0, At, B0); PG8_MMA(0, 1, At, B1); PG8_BAR; PG8_SCHED;
            PG8_LDA(At, 0, 1); PG8_STAGE(PG8_SB(0, 0), b2, voffB); PG8_STAGE(PG8_SB(0, 1), b2 + hstepB, voffB); PG8_STAGE(PG8_SA(0, 0), a2, voffA);
            PG8_WAIT_V(8); PG8_WAIT_L(0); PG8_BAR; PG8_MMA(1, 0, At, B0); PG8_MMA(1, 1, At, B1); PG8_BAR; PG8_SCHED;
            PG8_LDB(B0, 1, 0); PG8_LDB(B1, 1, 1); PG8_SCHED; PG8_LDA(At, 1, 0); PG8_STAGE(PG8_SA(0, 1), a2 + hstepA, voffA);
            PG8_WAIT_V(8); PG8_WAIT_L(0); PG8_BAR; PG8_MMA(0, 0, At, B0); PG8_MMA(0, 1, At, B1); PG8_BAR; PG8_SCHED;
            PG8_LDA(At, 1, 1); PG8_STAGE(PG8_SB(1, 0), b3, voffB); PG8_STAGE(PG8_SB(1, 1), b3 + hstepB, voffB); PG8_STAGE(PG8_SA(1, 0), a3, voffA);
            PG8_WAIT_V(8); PG8_WAIT_L(0); PG8_BAR; PG8_MMA(1, 0, At, B0); PG8_MMA(1, 1, At, B1); PG8_BAR; PG8_SCHED;
        }
        if (wr == 0) PG8_BAR;
        E(acc, cur, wr, wc, fr, fq);
        if (!has_next) break;
#pragma unroll
        for (int a = 0; a < 2; ++a)
#pragma unroll
            for (int b = 0; b < 2; ++b)
#pragma unroll
                for (int m = 0; m < 4; ++m)
#pragma unroll
                    for (int n = 0; n < 2; ++n) acc[a][b][m][n] = (f32x4){0.f, 0.f, 0.f, 0.f};
        cur = nxt; cA = nA; cB = nB; ++ui;
        if (wr == 1) PG8_BAR;
    }
    PG8_WAIT_V(0);
    PG8_BAR;
#undef PG8_SA
#undef PG8_SB
#undef PG8_STAGE
#undef PG8_LDA
#undef PG8_LDB
#undef PG8_MMA
#undef PG8_WAIT_V
#undef PG8_WAIT_L
#undef PG8_BAR
#undef PG8_SCHED
}

struct EpiSwiGLU {
    bf16_t* O;
    DI void operator()(const f32x4 (&acc)[2][2][4][2], const Unit& u, int wr, int wc, int fr, int fq) const {
        const int row0 = u.pm * BM + wr * 64 + fr, col0 = u.pn * 128 + wc * 32 + 8 * fq;
#pragma unroll
        for (int ai = 0; ai < 2; ++ai)
#pragma unroll
            for (int m = 0; m < 4; ++m) {
                bf16_t* rowp = O + (size_t)(row0 + ai * HALF + m * 16) * DFF + col0;
                const f32x4 g0 = acc[ai][0][m][0], g1 = acc[ai][0][m][1], u0 = acc[ai][1][m][0], u1 = acc[ai][1][m][1];
                u32x4 w;
                f32x4 e0, e1;
#pragma unroll
                for (int e = 0; e < 4; ++e) { e0[e] = __builtin_amdgcn_exp2f(-g0[e]); e1[e] = __builtin_amdgcn_exp2f(-g1[e]); }
                e0 = e0 + 1.0f; e1 = e1 + 1.0f;
#pragma unroll
                for (int e = 0; e < 4; ++e) { e0[e] = __builtin_amdgcn_rcpf(e0[e]); e1[e] = __builtin_amdgcn_rcpf(e1[e]); }
                const f32x4 r0 = g0 * u0 * e0, r1 = g1 * u1 * e1;
                w.x = pk2(r0[0], r0[1]); w.y = pk2(r0[2], r0[3]); w.z = pk2(r1[0], r1[1]); w.w = pk2(r1[2], r1[3]);
                *(u32x4*)rowp = w;
            }
    }
};
struct EpiStore {
    bf16_t* O; int ldc; size_t zO; float scale;
    DI void operator()(const f32x4 (&acc)[2][2][4][2], const Unit& u, int wr, int wc, int fr, int fq) const {
        const int row0 = u.pm * BM + wr * 64 + fr, col0 = u.pn * BM + wc * 32 + 8 * fq;
        bf16_t* base = O + (size_t)u.pz * zO;
#pragma unroll
        for (int ai = 0; ai < 2; ++ai)
#pragma unroll
            for (int m = 0; m < 4; ++m) {
                bf16_t* rowp = base + (size_t)(row0 + ai * HALF + m * 16) * ldc + col0;
#pragma unroll
                for (int bj = 0; bj < 2; ++bj) {
                    const f32x4 v0 = acc[ai][bj][m][0] * scale, v1 = acc[ai][bj][m][1] * scale;
                    u32x4 w; w.x = pk2(v0[0], v0[1]); w.y = pk2(v0[2], v0[3]); w.z = pk2(v1[0], v1[1]); w.w = pk2(v1[2], v1[3]);
                    *(u32x4*)(rowp + bj * HALF) = w;
                }
            }
    }
};
struct EpiResid {
    const float* srcL; const float* srcC; float* dstL; float* dstC; const float* gate; float coef;
    DI void operator()(const f32x4 (&acc)[2][2][4][2], const Unit& u, int wr, int wc, int fr, int fq) const {
        const bool isc = u.pm >= (TL / BM);
        const int bi = isc ? 16 : (u.pm >> 4);
        const int rloc = (isc ? (u.pm - TL / BM) : u.pm) * BM + wr * 64 + fr;
        const float* src = isc ? srcC : srcL; float* dst = isc ? dstC : dstL;
        const int col0 = u.pn * BM + wc * 32 + 8 * fq;
        const float* gp = gate + (size_t)bi * MODW + col0;
        f32x4 gv[2][2];
#pragma unroll
        for (int bj = 0; bj < 2; ++bj)
#pragma unroll
            for (int n = 0; n < 2; ++n) gv[bj][n] = *(const f32x4*)(gp + bj * HALF + 4 * n) * coef;
#pragma unroll
        for (int ai = 0; ai < 2; ++ai)
#pragma unroll
            for (int mp = 0; mp < 2; ++mp) {
                f32x4 sv[2][2][2];
#pragma unroll
                for (int m = 0; m < 2; ++m)
#pragma unroll
                    for (int bj = 0; bj < 2; ++bj)
#pragma unroll
                        for (int n = 0; n < 2; ++n) sv[m][bj][n] = *(const f32x4*)(src + (size_t)(rloc + ai * HALF + (2 * mp + m) * 16) * DM + col0 + bj * HALF + 4 * n);
#pragma unroll
                for (int m = 0; m < 2; ++m)
#pragma unroll
                    for (int bj = 0; bj < 2; ++bj)
#pragma unroll
                        for (int n = 0; n < 2; ++n) *(f32x4*)(dst + (size_t)(rloc + ai * HALF + (2 * mp + m) * 16) * DM + col0 + bj * HALF + 4 * n) = sv[m][bj][n] + gv[bj][n] * acc[ai][bj][2 * mp + m][n];
            }
    }
};
struct EpiFT {
    static constexpr bool HAS_POST = false;
    bf16_t* FT; bf16_t* FTC; bf16_t* VT;
    DI void operator()(const f32x4 (&acc)[2][2][4][2], const Unit& u, int wr, int wc, int fr, int fq) const {
        const bool isc = u.pn >= (TL / BM);
        bf16_t* base; size_t ld;
        if (u.pm < 3) { base = VT + (size_t)(u.pm * BM) * TT + (size_t)u.pn * BM; ld = TT; }
        else if (!isc) {
            const int b = u.pn >> 4, vt = u.pn & 15, part = u.pm - 3;
            if ((part == 0 && vt > 8) || (part == 1 && vt < 8)) return;
            base = FT + (size_t)b * 256 * 4096 + vt * BM; ld = 4096;
            if (vt == 8) {
                const int n0_ = wr * 64 + fr, c0_ = wc * 32 + 8 * fq;
#pragma unroll
                for (int ai = 0; ai < 2; ++ai)
#pragma unroll
                    for (int m = 0; m < 4; ++m) { bf16_t* rowp = base + (size_t)(n0_ + ai * HALF + m * 16) * ld + c0_;
#pragma unroll
                        for (int bj = 0; bj < 2; ++bj) { const f32x4 v0 = acc[ai][bj][m][0], v1 = acc[ai][bj][m][1];
                            const float ev[8] = {v0[0], v0[1], v0[2], v0[3], v1[0], v1[1], v1[2], v1[3]};
#pragma unroll
                            for (int e = 0; e < 8; ++e) { const int v = 2048 + bj * HALF + c0_ + e; const bool keep = part == 0 ? (v <= 2048) : (v > 2048);
                                if (keep) rowp[bj * HALF + e] = (bf16_t)(pk2(ev[e], 0.f) & 0xffffu); } } }
                return;
            }
        }
        else { const int b = u.pn - TL / BM; base = FTC + (size_t)b * 256 * 512 + (size_t)(u.pm - 3) * CTXL; ld = 512; }
        const int n0 = wr * 64 + fr, c0 = wc * 32 + 8 * fq;
#pragma unroll
        for (int ai = 0; ai < 2; ++ai)
#pragma unroll
            for (int m = 0; m < 4; ++m) {
                bf16_t* rowp = base + (size_t)(n0 + ai * HALF + m * 16) * ld + c0;
#pragma unroll
                for (int bj = 0; bj < 2; ++bj) {
                    const f32x4 v0 = acc[ai][bj][m][0], v1 = acc[ai][bj][m][1];
                    u32x4 w; w.x = pk2(v0[0], v0[1]); w.y = pk2(v0[2], v0[3]); w.z = pk2(v1[0], v1[1]); w.w = pk2(v1[2], v1[3]);
                    *(u32x4*)(rowp + bj * HALF) = w;
                }
            }
    }
};
}

struct Args { const float* in[19]; float* out; unsigned char* ws; };
struct Frame {
    LAS unsigned char* lds;
    int tid, lane, wave, vcu, G;
    float* out; unsigned char* ws;
};
#define WSP(T, off) ((T*)(F.ws + (off)))
DI const float* in_ptr(const Args& AR, int i) { asm volatile("" : "+s"(i)); return GLOBAL_PTR(const float, AR.in[i]); }

DI void transpose_item(const float* W, int ldw, int K, int nblk, bf16_t* WT, int mode, LAS float* scr, int item, int lane) {
    const int kb = item / nblk, nb = item % nblk, k0 = 64 * kb, n0 = 32 * nb;
    float wv[32];
#pragma unroll
    for (int i = 0; i < 32; ++i) wv[i] = W[(size_t)(k0 + 2 * i + (lane >> 5)) * ldw + n0 + (lane & 31)];
#pragma unroll
    for (int i = 0; i < 32; ++i) { const int kk = 2 * i + (lane >> 5); scr[kk * 33 + (lane & 31)] = wv[i]; }
    LDS_WAIT();
    int rbase = n0; float wsc = 1.0f;
    if (mode == 1) { if (n0 < DFF) { rbase = (n0 >> 7) * 256 + (n0 & 127); wsc = LOG2E; } else { const int j = n0 - DFF; rbase = (j >> 7) * 256 + 128 + (j & 127); wsc = 1.0f / LOG2E; } }
    const int c = lane & 7;
#pragma unroll
    for (int j = 0; j < 4; ++j) { const int n = (lane >> 3) + 8 * j; const LAS float* s = scr + (8 * c) * 33 + n;
        u32x4 o; o.x = pk2(s[0 * 33] * wsc, s[1 * 33] * wsc); o.y = pk2(s[2 * 33] * wsc, s[3 * 33] * wsc); o.z = pk2(s[4 * 33] * wsc, s[5 * 33] * wsc); o.w = pk2(s[6 * 33] * wsc, s[7 * 33] * wsc);
        *(u32x4*)(WT + (size_t)(rbase + n) * K + k0 + 8 * c) = o; }
    LDS_WAIT();
}

DI void prologue_a(Frame& F, const Args& AR, int ps_lo, int ps_hi) {
    LAS float* scr = (LAS float*)(F.lds + F.wave * 16384);
    LAS float* tw = (LAS float*)(F.lds + 131072);
    if (F.tid < 64) { tw[F.tid] = cospif((float)F.tid * (1.0f / 32.0f)); tw[64 + F.tid] = sinpif((float)F.tid * (1.0f / 32.0f)); }
    __syncthreads();
#pragma unroll 1
    for (int ps = ps_lo; ps < ps_hi; ++ps) {
    { int t_ = F.tid; asm volatile("" : "+v"(t_)); F.tid = t_; F.lane = t_ & 63; unsigned char* w_ = F.ws; asm volatile("" : "+s"(w_)); F.ws = GLOBAL_PTR(unsigned char, w_); }
    const int gw = F.vcu * 8 + F.wave, NGW = F.G * 8;
    const int gt = F.vcu * 512 + F.tid, NGT = F.G * 512;
    if (ps == 0) {
    constexpr int I0 = 8 * 16 * 176, I1 = 8 * 44 * 32, I2 = 2 * 16 * 72, I3 = 2 * 16 * 56, I4 = 4 * 16 * 32;
    for (int it = gw; it < I0 + I1 + I2 + I3 + I4; it += NGW) {
        int r = it;
        if (r < I0) { const int mt = r / (16 * 176), ii = r % (16 * 176); transpose_item(in_ptr(AR, 7) + (size_t)mt * DM * 2 * DFF, 2 * DFF, DM, 176, WSP(bf16_t, WS_WGU) + (size_t)mt * 2 * DFF * DM, 1, scr, ii, F.lane); continue; } r -= I0;
        if (r < I1) { const int mt = r / (44 * 32), ii = r % (44 * 32); transpose_item(in_ptr(AR, 8) + (size_t)mt * DFF * DM, DM, DFF, 32, WSP(bf16_t, WS_WD) + (size_t)mt * DM * DFF, 0, scr, ii, F.lane); continue; } r -= I1;
        if (r < I2) { const int mt = r / (16 * 72), ii = r % (16 * 72); transpose_item(in_ptr(AR, 9) + (size_t)mt * DM * 2560, 2560, DM, 72, WSP(bf16_t, WS_WINAB) + (size_t)mt * 2816 * DM, 0, scr, ii, F.lane); continue; } r -= I2;
        if (r < I3) { const int mt = r / (16 * 56), ii = r % (16 * 56); transpose_item(in_ptr(AR, 13) + (size_t)mt * DM * 1792, 1792, DM, 56, WSP(bf16_t, WS_WINCD) + (size_t)mt * 1792 * DM, 0, scr, ii, F.lane); continue; } r -= I3;
        { const int mt = r / (16 * 32), ii = r % (16 * 32); const float* src = (mt & 1) ? in_ptr(AR, 14) + (size_t)(mt >> 1) * DM * DM : in_ptr(AR, 10) + (size_t)(mt >> 1) * DM * DM;
          transpose_item(src, DM, DM, 32, WSP(bf16_t, WS_WOUT) + (size_t)mt * DM * DM, 0, scr, ii, F.lane); }
    }
    } else if (ps == 1) {
    for (int it = gw; it < 128; it += NGW) {
        const int i = it >> 6, g = (it >> 4) & 3, kb = it & 15, k = kb * 64 + F.lane;
        const float* wrow = in_ptr(AR, 9) + ((size_t)i * DM + k) * 2560 + 2304 + g * 64;
        float w[64];
#pragma unroll
        for (int c4 = 0; c4 < 16; ++c4) { const f32x4 v = *(const f32x4*)(wrow + 4 * c4); w[4 * c4] = v[0]; w[4 * c4 + 1] = v[1]; w[4 * c4 + 2] = v[2]; w[4 * c4 + 3] = v[3]; }
        bf16_t* WT = WSP(bf16_t, WS_WINAB) + (size_t)i * 2816 * DM;
        for (int cp = 0; cp < 64; ++cp) {
            float sc = 0.f, ss = 0.f;
#pragma unroll
            for (int c = 0; c < 64; ++c) { const int idx = (c * cp) & 63; sc += w[c] * tw[idx]; ss += w[c] * tw[64 + idx]; }
            WT[(size_t)(2304 + g * 64 + cp) * DM + k] = (bf16_t)(pk2(sc, 0.f) & 0xffffu);
            WT[(size_t)(2560 + g * 64 + cp) * DM + k] = (bf16_t)(pk2(ss, 0.f) & 0xffffu);
        }
    }
    } else if (ps == 2) {
    { const float* s = in_ptr(AR, 17); bf16_t* d = WSP(bf16_t, WS_WSB);
      for (int i = gt; i < 2 * 4 * 128 * 128 / 2; i += NGT) { const f32x2 v = *(const f32x2*)(s + 2 * i); ((unsigned*)d)[i] = pk2(v[0], v[1]); } }
    } else if (ps == 3) {
    { bf16_t* d = WSP(bf16_t, WS_DFT);
      for (int i = gt; i < SEQ * 512; i += NGT) { const int tp = i >> 9, k8 = (i & 511) * 8; float v[8];
#pragma unroll
          for (int e = 0; e < 8; ++e) { const int kk = k8 + e; const int k = kk <= 2048 ? kk : kk - 2048; const int j = (tp * k) & 4095; const float a = (float)j * (1.0f / 2048.0f); v[e] = (kk <= 2048) ? cospif(a) : -sinpif(a); }
          u32x4 o; o.x = pk2(v[0], v[1]); o.y = pk2(v[2], v[3]); o.z = pk2(v[4], v[5]); o.w = pk2(v[6], v[7]); *(u32x4*)(d + (size_t)i * 8) = o; }
      bf16_t* dc = WSP(bf16_t, WS_DFTC);
      for (int i = gt; i < CTXL * 64; i += NGT) { const int tp = i >> 6, k8 = (i & 63) * 8; float v[8];
#pragma unroll
          for (int e = 0; e < 8; ++e) { const int k = k8 + e; const int j = (tp * (k & 255)) & 255; const float a = (float)j * (1.0f / 128.0f); v[e] = (k < CTXL) ? cospif(a) : -sinpif(a); }
          u32x4 o; o.x = pk2(v[0], v[1]); o.y = pk2(v[2], v[3]); o.z = pk2(v[4], v[5]); o.w = pk2(v[6], v[7]); *(u32x4*)(dc + (size_t)i * 8) = o; } }
    } else if (ps == 4) {
    { float* rp = WSP(float, WS_ROPE);
      for (int i = gt; i < 1024; i += NGT) { const int pos = i >> 4, f = i & 15; const float inv = exp2f(-(float)f * (13.287712379549449f / 16.0f));
          const float ang = (float)pos * inv; const float rev = ang * 0.15915494309189535f; const float fr = rev - floorf(rev);
          rp[2 * i] = cospif(2.0f * fr); rp[2 * i + 1] = sinpif(2.0f * fr); } }
    } else {
    for (int it = gw; it < 4 * 36 * 8; it += NGW) {
        const int l = it / 288, rem = it % 288, cgp = rem >> 3, kc = rem & 7;
        LAS float* sl = scr;
        for (int e = F.lane; e < NBI * 128; e += 64) { const int bi = e >> 7, kk = e & 127; const float cv = bi < 16 ? in_ptr(AR, 1)[bi * DM + kc * 128 + kk] : in_ptr(AR, 3)[kc * 128 + kk]; sl[e] = silu_f(cv); }
        LDS_WAIT();
        f32x4 acc[NBI];
#pragma unroll
        for (int bi = 0; bi < NBI; ++bi) acc[bi] = (f32x4){0.f, 0.f, 0.f, 0.f};
        const int col = cgp * 256 + F.lane * 4;
        const float* wp = in_ptr(AR, 5) + ((size_t)l * DM + kc * 128) * MODW + col;
#pragma unroll 4
        for (int kk = 0; kk < 128; ++kk) { const f32x4 w = *(const f32x4*)(wp + (size_t)kk * MODW);
#pragma unroll
            for (int bi = 0; bi < NBI; ++bi) acc[bi] += w * sl[bi * 128 + kk]; }
        float* dp = WSP(float, WS_MODP) + (size_t)kc * (4 * NBI * MODW) + (size_t)l * NBI * MODW + col;
#pragma unroll
        for (int bi = 0; bi < NBI; ++bi) *(f32x4*)(dp + (size_t)bi * MODW) = acc[bi];
        LDS_WAIT();
    }
    }
    }
}
DI void prologue_b(Frame& F, const Args& AR) {
    const int gt = F.vcu * 512 + F.tid, NGT = F.G * 512;
    const float* mp = WSP(float, WS_MODP); float* md = WSP(float, WS_MOD);
    for (int i = gt; i < 4 * NBI * MODW / 4; i += NGT) {
        const int l = i / (NBI * MODW / 4), n4 = i % (MODW / 4);
        f32x4 s = *(const f32x4*)(in_ptr(AR, 6) + (size_t)l * MODW + 4 * n4);
#pragma unroll
        for (int kc = 0; kc < 8; ++kc) s += *(const f32x4*)(mp + (size_t)kc * (4 * NBI * MODW) + (size_t)i * 4);
        *(f32x4*)(md + (size_t)i * 4) = s;
    }
}

DI void norm_phase(Frame& F, const float* srcL, const float* srcC, const float* g, const float* modl, int sub) {
    const int gw = F.vcu * 8 + F.wave; constexpr int RPW = TT / 2048;
    bf16_t* H = WSP(bf16_t, WS_H);
    int cur_bi = -1; f32x4 gs[4], sh[4];
    for (int row = gw * RPW; row < gw * RPW + RPW; ++row) {
        const int bi = row < TL ? (row >> 12) : 16;
        if (bi != cur_bi) { cur_bi = bi; const float* mp = modl + (size_t)bi * MODW + sub * 3072;
#pragma unroll
            for (int j = 0; j < 4; ++j) { const int k = (F.lane + 64 * j) * 4; const f32x4 gg = *(const f32x4*)(g + k), sc = *(const f32x4*)(mp + 1024 + k); sh[j] = *(const f32x4*)(mp + k); gs[j] = gg * (sc + 1.0f); } }
        const float* src = row < TL ? srcL + (size_t)row * DM : srcC + (size_t)(row - TL) * DM;
        f32x4 v[4]; float ss = 0.f;
#pragma unroll
        for (int j = 0; j < 4; ++j) { v[j] = __builtin_nontemporal_load((const f32x4*)(src + (F.lane + 64 * j) * 4)); ss += (v[j][0] * v[j][0] + v[j][1] * v[j][1]) + (v[j][2] * v[j][2] + v[j][3] * v[j][3]); }
        const float rstd = rsqrtf(wave_sum(ss) * (1.0f / DM) + EPS);
        bf16_t* hp = H + (size_t)row * DM;
#pragma unroll
        for (int j = 0; j < 4; ++j) { const f32x4 o = v[j] * rstd * gs[j] + sh[j]; u32x2 w; w.x = pk2(o[0], o[1]); w.y = pk2(o[2], o[3]); *(u32x2*)(hp + (F.lane + 64 * j) * 4) = w; }
    }
}

DI void norm_pair_phase(Frame& F, const float* srcL, const float* srcC, const float* g, const float* modl, int sub) {
    bf16_t* H = WSP(bf16_t, WS_H); bf16_t* HS = WSP(bf16_t, WS_HS);
    const int gw = F.vcu * 8 + F.wave, NGW = F.G * 8, lane = F.lane;
    int cur_bi = -1; f32x4 gs[4], sh[4];
    const int NT_L = NB * 2049, NT = NT_L + TC / 2;
    for (int task = gw; task < NT; task += NGW) {
        int bi, r1, r2, j; bool single, isc = task >= NT_L;
        if (!isc) { bi = task / 2049; j = task % 2049; single = (j == 0 || j == 2048); r1 = bi * SEQ + j; r2 = single ? r1 : bi * SEQ + SEQ - j; }
        else { bi = 16; j = 0; single = false; r1 = TL + 2 * (task - NT_L); r2 = r1 + 1; }
        if (bi != cur_bi) { cur_bi = bi; const float* mp = modl + (size_t)bi * MODW + sub * 3072;
#pragma unroll
            for (int q = 0; q < 4; ++q) { const int k = (lane + 64 * q) * 4; const f32x4 gg = *(const f32x4*)(g + k), sc = *(const f32x4*)(mp + 1024 + k); sh[q] = *(const f32x4*)(mp + k); gs[q] = gg * (sc + 1.0f); } }
        const float* s1 = r1 < TL ? srcL + (size_t)r1 * DM : srcC + (size_t)(r1 - TL) * DM;
        const float* s2 = r2 < TL ? srcL + (size_t)r2 * DM : srcC + (size_t)(r2 - TL) * DM;
        f32x4 v1[4], v2[4]; float ss1 = 0.f, ss2 = 0.f;
#pragma unroll
        for (int q = 0; q < 4; ++q) { v1[q] = __builtin_nontemporal_load((const f32x4*)(s1 + (lane + 64 * q) * 4)); v2[q] = __builtin_nontemporal_load((const f32x4*)(s2 + (lane + 64 * q) * 4)); }
#pragma unroll
        for (int q = 0; q < 4; ++q) { ss1 += (v1[q][0] * v1[q][0] + v1[q][1] * v1[q][1]) + (v1[q][2] * v1[q][2] + v1[q][3] * v1[q][3]); ss2 += (v2[q][0] * v2[q][0] + v2[q][1] * v2[q][1]) + (v2[q][2] * v2[q][2] + v2[q][3] * v2[q][3]); }
#pragma unroll
        for (int o = 1; o < 64; o <<= 1) { ss1 += __shfl_xor(ss1, o); ss2 += __shfl_xor(ss2, o); }
        const float rs1 = rsqrtf(ss1 * (1.0f / DM) + EPS), rs2 = rsqrtf(ss2 * (1.0f / DM) + EPS);
        bf16_t* h1 = H + (size_t)r1 * DM; bf16_t* h2 = H + (size_t)r2 * DM;
        bf16_t* hp = HS + (size_t)(isc ? r1 : bi * SEQ + j) * DM; bf16_t* hm = HS + (size_t)(isc ? r2 : bi * SEQ + 2048 + j) * DM;
#pragma unroll
        for (int q = 0; q < 4; ++q) {
            const f32x4 o1 = v1[q] * rs1 * gs[q] + sh[q], o2 = v2[q] * rs2 * gs[q] + sh[q];
            const int c = (lane + 64 * q) * 4;
            u32x2 w; w.x = pk2(o1[0], o1[1]); w.y = pk2(o1[2], o1[3]); *(u32x2*)(h1 + c) = w;
            if (!single) { u32x2 w2; w2.x = pk2(o2[0], o2[1]); w2.y = pk2(o2[2], o2[3]); *(u32x2*)(h2 + c) = w2; }
            if (isc) { *(u32x2*)(hp + c) = w; u32x2 w2; w2.x = pk2(o2[0], o2[1]); w2.y = pk2(o2[2], o2[3]); *(u32x2*)(hm + c) = w2; }
            else if (single) { *(u32x2*)(hp + c) = w; }
            else { const f32x4 sp = o1 + o2, sm = o1 - o2; u32x2 wp, wm; wp.x = pk2(sp[0], sp[1]); wp.y = pk2(sp[2], sp[3]); wm.x = pk2(sm[0], sm[1]); wm.y = pk2(sm[2], sm[3]);
                   *(u32x2*)(hp + c) = wp; *(u32x2*)(hm + c) = wm; }
        }
    }
}

DI void postpass(Frame& F, bool even, const float* qkg  ) {
    bf16_t* P = WSP(bf16_t, WS_BIG); bf16_t* VT = WSP(bf16_t, WS_VT);
    const int ldp = even ? LDP_E : LDP_O, kcol0 = even ? 768 : 512, nqk = even ? 12 : 2, vcol0 = 640, nvb = even ? 0 : 2;
    const float* rope = WSP(float, WS_ROPE);
    const int gt = F.vcu * 512 + F.tid, NGT = F.G * 512;
    const int total = TT * nqk;
    for (int idx = gt; idx < total; idx += NGT) {
        const int row = idx / nqk, hs = idx % nqk;
        bf16_t* p = P + (size_t)row * ldp + kcol0 + hs * 64;
        const float* gv = qkg + 64;
        bf16x8 raw[8]; float x[64]; float ss = 0.f;
#pragma unroll
        for (int j = 0; j < 8; ++j) raw[j] = *(const bf16x8*)(p + 8 * j);
#pragma unroll
        for (int j = 0; j < 8; ++j)
#pragma unroll
            for (int e = 0; e < 8; ++e) { const float v = bf2f(raw[j][e]); x[8 * j + e] = v; ss += v * v; }
        const float rstd = rsqrtf(ss * (1.0f / 64.0f) + EPS);
#pragma unroll
        for (int d = 0; d < 64; ++d) x[d] = x[d] * rstd * gv[d];
        if (!even && row < TL) {
            const int t = row & (SEQ - 1), pr = t >> 6, pc = t & 63;
#pragma unroll
            for (int i = 0; i < 32; ++i) { const f32x2 cs = *(const f32x2*)(rope + ((i < 16 ? pr : pc) * 16 + (i & 15)) * 2);
                const float x0 = x[2 * i], x1 = x[2 * i + 1]; x[2 * i] = x0 * cs[0] - x1 * cs[1]; x[2 * i + 1] = x0 * cs[1] + x1 * cs[0]; }
        }
#pragma unroll
        for (int j = 0; j < 8; ++j) { u32x4 w; w.x = pk2(x[8 * j], x[8 * j + 1]); w.y = pk2(x[8 * j + 2], x[8 * j + 3]); w.z = pk2(x[8 * j + 4], x[8 * j + 5]); w.w = pk2(x[8 * j + 6], x[8 * j + 7]); *(u32x4*)(p + 8 * j) = w; }
    }
    __syncthreads();
    LAS bf16_t* T = (LAS bf16_t*)(F.lds + F.wave * 16384);
    const int gw = F.vcu * 8 + F.wave, NGW = F.G * 8;
    for (int it = gw; it < (TT / 64) * nvb; it += NGW) {
        const int tt = it / nvb, cb = it % nvb;
        const bf16_t* src = P + (size_t)(tt * 64 + F.lane) * ldp + vcol0 + cb * 64;
#pragma unroll
        for (int j = 0; j < 8; ++j) { const bf16x8 v = *(const bf16x8*)(src + 8 * j);
#pragma unroll
            for (int e = 0; e < 8; ++e) T[(8 * j + e) * 72 + F.lane] = (bf16_t)v[e]; }
        LDS_WAIT();
        bf16_t* dst = VT + (size_t)(cb * 64 + F.lane) * TT + tt * 64;
#pragma unroll
        for (int j = 0; j < 8; ++j) { const u32x4 v = *(const LAS u32x4*)(T + F.lane * 72 + 8 * j); *(u32x4*)(dst + 8 * j) = v; }
        LDS_WAIT();
    }
}

template <bool ROPE>
DI void q_prep(bf16x8& q0, bf16x8& q1, const float* gq, int g, const float* rope, int t) {
    float x[16]; float ss = 0.f;
#pragma unroll
    for (int e = 0; e < 8; ++e) { x[e] = bf2f(q0[e]); x[8 + e] = bf2f(q1[e]); ss += x[e] * x[e] + x[8 + e] * x[8 + e]; }
    ss += __shfl_xor(ss, 16); ss += __shfl_xor(ss, 32);
    const float rstd = rsqrtf(ss * (1.0f / 64.0f) + EPS);
    const f32x4 ga = *(const f32x4*)(gq + 8 * g), gb = *(const f32x4*)(gq + 8 * g + 4), gc = *(const f32x4*)(gq + 32 + 8 * g), gd = *(const f32x4*)(gq + 32 + 8 * g + 4);
#pragma unroll
    for (int e = 0; e < 4; ++e) { x[e] *= rstd * ga[e]; x[4 + e] *= rstd * gb[e]; x[8 + e] *= rstd * gc[e]; x[12 + e] *= rstd * gd[e]; }
    if (ROPE) {
        const float* rr = rope + ((t >> 6) * 16 + 4 * g) * 2; const float* rc = rope + ((t & 63) * 16 + 4 * g) * 2;
        const f32x4 r0 = *(const f32x4*)rr, r1 = *(const f32x4*)(rr + 4), c0 = *(const f32x4*)rc, c1 = *(const f32x4*)(rc + 4);
        const float cs[8] = {r0[0], r0[2], r1[0], r1[2], c0[0], c0[2], c1[0], c1[2]}, sn[8] = {r0[1], r0[3], r1[1], r1[3], c0[1], c0[3], c1[1], c1[3]};
#pragma unroll
        for (int i = 0; i < 8; ++i) { const float a = x[2 * i], b = x[2 * i + 1]; x[2 * i] = a * cs[i] - b * sn[i]; x[2 * i + 1] = a * sn[i] + b * cs[i]; }
    }
    u32x4 w0, w1; w0.x = pk2(x[0], x[1]); w0.y = pk2(x[2], x[3]); w0.z = pk2(x[4], x[5]); w0.w = pk2(x[6], x[7]); w1.x = pk2(x[8], x[9]); w1.y = pk2(x[10], x[11]); w1.z = pk2(x[12], x[13]); w1.w = pk2(x[14], x[15]);
    q0 = __builtin_bit_cast(bf16x8, w0); q1 = __builtin_bit_cast(bf16x8, w1);
}
struct KVf { bf16x8 k00, k01, k10, k11; };
struct VVf { bf16x8 v0, v1, v2, v3; };
DI bf16x8 ldv8(const bf16_t* p) { const s16x4 lo = *(const s16x4*)p, hi = *(const s16x4*)(p + 16); return (bf16x8){lo[0], lo[1], lo[2], lo[3], hi[0], hi[1], hi[2], hi[3]}; }
DI void k_load(KVf& f, const bf16_t* kp, size_t kpitch) {
    f.k00 = *(const bf16x8*)kp; f.k01 = *(const bf16x8*)(kp + 32); f.k10 = *(const bf16x8*)(kp + 16 * kpitch); f.k11 = *(const bf16x8*)(kp + 16 * kpitch + 32);
}
DI void v_load(VVf& f, const bf16_t* vp, size_t vpitch) {
    f.v0 = ldv8(vp); f.v1 = ldv8(vp + 16 * vpitch); f.v2 = ldv8(vp + 32 * vpitch); f.v3 = ldv8(vp + 48 * vpitch);
}
#define MFMA16(a, b, c) __builtin_amdgcn_mfma_f32_16x16x32_bf16((a), (b), (c), 0, 0, 0)
template <int NH, bool BIAS>
DI void attn_compute(f32x4 (&o)[NH][4], float (&mx)[NH], float (&ls)[NH], const bf16x8 (&q)[NH][2], const KVf& f, const VVf& fv, f32x4 b0, f32x4 b1, unsigned vm) {
    const f32x4 z = {0.f, 0.f, 0.f, 0.f};
    constexpr float C = 0.125f * LOG2E;
#pragma unroll
    for (int h = 0; h < NH; ++h) {
        f32x4 s0 = MFMA16(f.k00, q[h][0], z); s0 = MFMA16(f.k01, q[h][1], s0);
        f32x4 s1 = MFMA16(f.k10, q[h][0], z); s1 = MFMA16(f.k11, q[h][1], s1);
        s0 = s0 * C; s1 = s1 * C;
        if (BIAS) { s0 += b0; s1 += b1;
#pragma unroll
            for (int e = 0; e < 4; ++e) { if (!((vm >> e) & 1u)) s0[e] = -1e30f; if (!((vm >> (4 + e)) & 1u)) s1[e] = -1e30f; } }
        float t = fmaxf(fmaxf(fmaxf(s0[0], s0[1]), fmaxf(s0[2], s0[3])), fmaxf(fmaxf(s1[0], s1[1]), fmaxf(s1[2], s1[3])));
        t = fmaxf(t, __shfl_xor(t, 16)); t = fmaxf(t, __shfl_xor(t, 32));
        const float mn = fmaxf(mx[h], t); const float al = __builtin_amdgcn_exp2f(mx[h] - mn); mx[h] = mn;
        f32x4 p0, p1;
#pragma unroll
        for (int e = 0; e < 4; ++e) { p0[e] = __builtin_amdgcn_exp2f(s0[e] - mn); p1[e] = __builtin_amdgcn_exp2f(s1[e] - mn); }
        ls[h] = ls[h] * al + ((p0[0] + p0[1]) + (p0[2] + p0[3])) + ((p1[0] + p1[1]) + (p1[2] + p1[3]));
        u32x4 pw; pw.x = pk2(p0[0], p0[1]); pw.y = pk2(p0[2], p0[3]); pw.z = pk2(p1[0], p1[1]); pw.w = pk2(p1[2], p1[3]);
        const bf16x8 pb = __builtin_bit_cast(bf16x8, pw);
        o[h][0] = MFMA16(fv.v0, pb, o[h][0] * al); o[h][1] = MFMA16(fv.v1, pb, o[h][1] * al);
        o[h][2] = MFMA16(fv.v2, pb, o[h][2] * al); o[h][3] = MFMA16(fv.v3, pb, o[h][3] * al);
    }
}
template <int NH, bool BIAS>
DI void attn_unit(const bf16_t* qp, const bf16_t* kA, const bf16_t* vA, int nA, int strideA, const bf16_t* kB, const bf16_t* vB, int nB, size_t kpitch,
                  bf16_t* op  , const float* rpbh, int drow0, const int (&dc)[8], unsigned vmask, const float* gq, int g) {
    bf16x8 q[NH][2]; f32x4 o[NH][4]; float mx[NH], ls[NH];
#pragma unroll
    for (int h = 0; h < NH; ++h) { q[h][0] = *(const bf16x8*)(qp + h * 64); q[h][1] = *(const bf16x8*)(qp + h * 64 + 32); q_prep<false>(q[h][0], q[h][1], gq, g, nullptr, 0); mx[h] = -1e30f; ls[h] = 0.f;
#pragma unroll
        for (int d = 0; d < 4; ++d) o[h][d] = (f32x4){0.f, 0.f, 0.f, 0.f}; }
    const int n = nA + nB;
    const size_t vpitch = TT;
    KVf fa, fb; VVf fv;
#define SEG_K(s) ((s) < nA ? kA + (size_t)(s) * strideA * kpitch : kB + (size_t)((s) - nA) * 32 * kpitch)
#define SEG_V(s) ((s) < nA ? vA + (size_t)(s) * strideA : vB + (size_t)((s) - nA) * 32)
    k_load(fa, SEG_K(0), kpitch);
    for (int s = 0; s < n; s += 2) {
        v_load(fv, SEG_V(s), vpitch); k_load(fb, SEG_K(s + 1), kpitch);
        {
            f32x4 b0 = {0.f, 0.f, 0.f, 0.f}, b1 = b0; unsigned vm = 0xffu;
            if (BIAS && s < nA) { const float* rp = rpbh + (drow0 + s) * 31; vm = vmask;
#pragma unroll
                for (int e = 0; e < 4; ++e) { b0[e] = rp[dc[e]] * LOG2E; b1[e] = rp[dc[4 + e]] * LOG2E; } }
            attn_compute<NH, BIAS>(o, mx, ls, q, fa, fv, b0, b1, vm);
        }
        v_load(fv, SEG_V(s + 1), vpitch); if (s + 2 < n) k_load(fa, SEG_K(s + 2), kpitch);
        {
            f32x4 b0 = {0.f, 0.f, 0.f, 0.f}, b1 = b0; unsigned vm = 0xffu;
            if (BIAS && s + 1 < nA) { const float* rp = rpbh + (drow0 + s + 1) * 31; vm = vmask;
#pragma unroll
                for (int e = 0; e < 4; ++e) { b0[e] = rp[dc[e]] * LOG2E; b1[e] = rp[dc[4 + e]] * LOG2E; } }
            attn_compute<NH, BIAS>(o, mx, ls, q, fb, fv, b0, b1, vm);
        }
    }
#undef SEG_K
#undef SEG_V
#pragma unroll
    for (int h = 0; h < NH; ++h) {
        float l = ls[h]; l += __shfl_xor(l, 16); l += __shfl_xor(l, 32);
        const float inv = 1.0f / l;
#pragma unroll
        for (int d = 0; d < 4; ++d) { const f32x4 v = o[h][d] * inv; u32x2 w; w.x = pk2(v[0], v[1]); w.y = pk2(v[2], v[3]); *(u32x2*)(op + h * 64 + d * 16) = w; }
    }
}

DI void attn_even(Frame& F, const float* rpb  , const float* gq) {
    const bf16_t* P = WSP(bf16_t, WS_BIG); const bf16_t* VT = WSP(bf16_t, WS_VT); bf16_t* MIX = WSP(bf16_t, WS_H);
    const int l16 = F.lane & 15, g = F.lane >> 4;
    const size_t kp = LDP_E;
    const int gw = F.vcu * 8 + F.wave, NGW = F.G * 8;
    const int dz[8] = {0, 0, 0, 0, 0, 0, 0, 0};
    for (int wu = gw; wu < NB * 12 * 16; wu += NGW) {
        const int b = wu / 192, h = (wu % 192) >> 4, qb = wu & 15;
        const int qrow = TL + b * CTXL + qb * 16 + l16;
        const bf16_t* kB = P + (size_t)(TL + b * CTXL + l16) * kp + 768 + h * 64 + g * 8;
        const bf16_t* vB = VT + (size_t)(h * 64 + l16) * TT + TL + b * CTXL + 4 * g;
        attn_unit<1, false>(P + (size_t)qrow * kp + h * 64 + g * 8, kB, vB, 0, 32, kB, vB, 8, kp, MIX + (size_t)qrow * DM + h * 64 + 4 * g, rpb, 0, dz, 0xffu, gq, g);
    }
}
DI void attn_odd(Frame& F, const float* gq) {
    const bf16_t* P = WSP(bf16_t, WS_BIG); const bf16_t* VT = WSP(bf16_t, WS_VT); bf16_t* MIX = WSP(bf16_t, WS_H);
    const int l16 = F.lane & 15, g = F.lane >> 4;
    const size_t kp = LDP_O;
    const int dz[8] = {0, 0, 0, 0, 0, 0, 0, 0};
    const int gw = F.vcu * 8 + F.wave, NGW = F.G * 8;
    for (int wu = gw; wu < NB * 2 * 16; wu += NGW) {
        const int b = wu >> 5, kvh = (wu >> 4) & 1, qb = wu & 15;
        const int qrow = TL + b * CTXL + qb * 16 + l16;
        const bf16_t* kB = P + (size_t)(TL + b * CTXL + l16) * kp + 512 + kvh * 64 + g * 8;
        const bf16_t* vB = VT + (size_t)(kvh * 64 + l16) * TT + TL + b * CTXL + 4 * g;
        attn_unit<4, false>(P + (size_t)qrow * kp + kvh * 256 + g * 8, kB, vB, 0, 32, kB, vB, 8, kp, MIX + (size_t)qrow * DM + kvh * 256 + 4 * g, nullptr, 0, dz, 0xffu, gq, g);
    }
}

constexpr int AT_GRP = 1152, AT_VOFF = 8 * AT_GRP, AT_SLOT = 2 * AT_VOFF;
DI void glds16s(const void* sbase, unsigned voff, unsigned lds_dst) { unsigned keep;
    asm volatile("s_mov_b32 %0, m0\n\ts_mov_b32 m0, %3\n\ts_nop 0\n\tglobal_load_lds_dwordx4 %1, %2\n\ts_mov_b32 m0, %0" : "=&s"(keep) : "v"(voff), "s"(sbase), "s"(lds_dst) : "memory"); }
#define LDS_K(sk, keybase, kb, dh) (*(const LAS bf16x8*)((sk) + (((keybase) >> 3) + 2 * (kb)) * AT_GRP + (dh) * 512))
DI bf16x8 lds_v(const LAS unsigned char* sv, int off) {
    const s16x4 lo = *(const LAS s16x4*)(sv + off), hi = *(const LAS s16x4*)(sv + off + 256);
    return (bf16x8){lo[0], lo[1], lo[2], lo[3], hi[0], hi[1], hi[2], hi[3]};
}
#define LDS_V(sv, db, cb) lds_v((sv), 2 * (db) * AT_GRP + (cb) * 128)
#define AT_WAIT_BAR(N) asm volatile("s_waitcnt vmcnt(" #N ") lgkmcnt(0)\n\ts_barrier" ::: "memory")
template <bool BIAS>
DI void attn_head(f32x4 (&o)[4], float mref, float& ls, bf16x8 q0, bf16x8 q1, bf16x8 k00, bf16x8 k01, bf16x8 k10, bf16x8 k11,
                  bf16x8 v0, bf16x8 v1, bf16x8 v2, bf16x8 v3, f32x4 b0, f32x4 b1, unsigned vm) {
    const f32x4 z = {0.f, 0.f, 0.f, 0.f};
    constexpr float C = 0.125f * LOG2E;
    f32x4 s0 = MFMA16(k00, q0, z); s0 = MFMA16(k01, q1, s0);
    f32x4 s1 = MFMA16(k10, q0, z); s1 = MFMA16(k11, q1, s1);
    f32x4 p0, p1;
#pragma unroll
    for (int e = 0; e < 4; ++e) {
        if (BIAS) { p0[e] = __builtin_amdgcn_exp2f(__builtin_fmaf(s0[e], C, b0[e] - mref)); p1[e] = __builtin_amdgcn_exp2f(__builtin_fmaf(s1[e], C, b1[e] - mref));
                    if (!((vm >> e) & 1u)) p0[e] = 0.f; if (!((vm >> (4 + e)) & 1u)) p1[e] = 0.f; }
        else { p0[e] = __builtin_amdgcn_exp2f(__builtin_fmaf(s0[e], C, -mref)); p1[e] = __builtin_amdgcn_exp2f(__builtin_fmaf(s1[e], C, -mref)); } }
    ls += ((p0[0] + p0[1]) + (p0[2] + p0[3])) + ((p1[0] + p1[1]) + (p1[2] + p1[3]));
    u32x4 pw; pw.x = pk2(p0[0], p0[1]); pw.y = pk2(p0[2], p0[3]); pw.z = pk2(p1[0], p1[1]); pw.w = pk2(p1[2], p1[3]);
    const bf16x8 pb = __builtin_bit_cast(bf16x8, pw);
    o[0] = MFMA16(v0, pb, o[0]); o[1] = MFMA16(v1, pb, o[1]); o[2] = MFMA16(v2, pb, o[2]); o[3] = MFMA16(v3, pb, o[3]);
}
DI void attn_group4(f32x4 (&o)[4][4], const float (&mref)[4], float (&ls)[4], const bf16x8 (&q)[4][2], bf16x8 k00, bf16x8 k01, bf16x8 k10, bf16x8 k11,
                    bf16x8 v0, bf16x8 v1, bf16x8 v2, bf16x8 v3) {
    const f32x4 z = {0.f, 0.f, 0.f, 0.f};
    constexpr float C = 0.125f * LOG2E;
    f32x4 s0[4], s1[4];
    __builtin_amdgcn_s_setprio(1);
#pragma unroll
    for (int h = 0; h < 4; ++h) { s0[h] = MFMA16(k00, q[h][0], z); s1[h] = MFMA16(k10, q[h][0], z); }
#pragma unroll
    for (int h = 0; h < 4; ++h) { s0[h] = MFMA16(k01, q[h][1], s0[h]); s1[h] = MFMA16(k11, q[h][1], s1[h]); }
    __builtin_amdgcn_s_setprio(0);
    bf16x8 pb[4];
#pragma unroll
    for (int h = 0; h < 4; ++h) {
        f32x4 p0, p1;
#pragma unroll
        for (int e = 0; e < 4; ++e) { p0[e] = __builtin_amdgcn_exp2f(__builtin_fmaf(s0[h][e], C, -mref[h])); p1[e] = __builtin_amdgcn_exp2f(__builtin_fmaf(s1[h][e], C, -mref[h])); }
        ls[h] += ((p0[0] + p0[1]) + (p0[2] + p0[3])) + ((p1[0] + p1[1]) + (p1[2] + p1[3]));
        u32x4 pw; pw.x = pk2(p0[0], p0[1]); pw.y = pk2(p0[2], p0[3]); pw.z = pk2(p1[0], p1[1]); pw.w = pk2(p1[2], p1[3]);
        pb[h] = __builtin_bit_cast(bf16x8, pw);
    }
    __builtin_amdgcn_s_setprio(1);
#pragma unroll
    for (int h = 0; h < 4; ++h) { o[h][0] = MFMA16(v0, pb[h], o[h][0]); o[h][1] = MFMA16(v1, pb[h], o[h][1]); o[h][2] = MFMA16(v2, pb[h], o[h][2]); o[h][3] = MFMA16(v3, pb[h], o[h][3]); }
    __builtin_amdgcn_s_setprio(0);
}
DI float q_norm(bf16x8 q0, bf16x8 q1) {
    float ss = 0.f;
#pragma unroll
    for (int e = 0; e < 8; ++e) { const float a = bf2f(q0[e]), b = bf2f(q1[e]); ss += a * a + b * b; }
    ss += __shfl_xor(ss, 16); ss += __shfl_xor(ss, 32);
    return sqrtf(ss);
}
DI float wave_max(float v) {
#pragma unroll
    for (int o = 1; o < 64; o <<= 1) v = fmaxf(v, __shfl_xor(v, o));
    return v;
}
DI void attn_store(bf16_t* op, const f32x4 (&o)[4], float ls) {
    float l = ls; l += __shfl_xor(l, 16); l += __shfl_xor(l, 32);
    const float inv = 1.0f / l;
#pragma unroll
    for (int d = 0; d < 4; ++d) { const f32x4 v = o[d] * inv; u32x2 w; w.x = pk2(v[0], v[1]); w.y = pk2(v[2], v[3]); *(u32x2*)(op + d * 16) = w; }
}

DI void attn_odd_lds(Frame& F, const float* gk  , const float* gq  , bool with_ctx) {
    const bf16_t* P = WSP(bf16_t, WS_BIG); const bf16_t* VT = WSP(bf16_t, WS_VT); bf16_t* MIX = WSP(bf16_t, WS_H);
    const int l16 = F.lane & 15, g = F.lane >> 4;
    const size_t kp = LDP_O;
    const unsigned lds0 = (unsigned)(uintptr_t)F.lds;
    const int drow = F.wave * 8 + (F.lane & 7), dsw = (F.lane >> 3) * 8;
    const unsigned koff = (unsigned)(drow * (int)kp + dsw) * 2u, voff = (unsigned)(drow * TT + dsw) * 2u;
    const unsigned wofs = (unsigned)F.wave * AT_GRP;
    const float kn = 8.0f * 1.01f * wave_max(fabsf(gk[F.lane])) * (0.125f * LOG2E);
    const int bk = (l16 >> 3) * AT_GRP + (l16 & 7) * 16 + g * 128, bv = AT_VOFF + (l16 >> 3) * AT_GRP + (l16 & 7) * 16 + (g >> 1) * 128 + (g & 1) * 8;
    __syncthreads();
    for (int item = F.vcu; item < NB * 2 * 32 + (with_ctx ? NB * 2 * 2 : 0); item += F.G) {
        const bool isc = item >= NB * 2 * 32; const int ci = item - NB * 2 * 32;
        const int b = isc ? (ci >> 2) : (item >> 6), kvh = isc ? ((ci >> 1) & 1) : ((item >> 5) & 1);
        const int tq = isc ? (ci & 1) * 128 : (item & 31) * 128;
        const int qbase = (isc ? TL + b * CTXL : b * SEQ) + tq + F.wave * 16;
        const int nlat = isc ? 0 : 64;
        const int qrow = qbase + l16;
        const bf16_t* qp = P + (size_t)qrow * kp + kvh * 256 + g * 8;
        bf16x8 q[4][2]; f32x4 o[4][4]; float mx[4], ls[4];
#pragma unroll
        for (int h = 0; h < 4; ++h) { q[h][0] = *(const bf16x8*)(qp + h * 64); q[h][1] = *(const bf16x8*)(qp + h * 64 + 32); { int gl_ = g; asm volatile("" : "+v"(gl_)); if (isc) q_prep<false>(q[h][0], q[h][1], gq, gl_, nullptr, 0); else q_prep<true>(q[h][0], q[h][1], gq, gl_, WSP(float, WS_ROPE), tq + F.wave * 16 + l16); } mx[h] = q_norm(q[h][0], q[h][1]) * kn; ls[h] = 0.f;
#pragma unroll
            for (int d = 0; d < 4; ++d) o[h][d] = (f32x4){0.f, 0.f, 0.f, 0.f}; }
        const bf16_t* Kl = P + (size_t)(b * SEQ) * kp + 512 + kvh * 64; const bf16_t* Vl = VT + (size_t)(kvh * 64) * TT + b * SEQ;
        const bf16_t* Kc = P + (size_t)(TL + b * CTXL) * kp + 512 + kvh * 64; const bf16_t* Vc = VT + (size_t)(kvh * 64) * TT + TL + b * CTXL;
        const int n = nlat + 4;
#define AT_ISSUE(s) do { const int s_ = (s); const bf16_t* kt_ = s_ < nlat ? Kl + (size_t)s_ * 64 * kp : Kc + (size_t)(s_ - nlat) * 64 * kp; const bf16_t* vt_ = s_ < nlat ? Vl + s_ * 64 : Vc + (s_ - nlat) * 64; \
        const unsigned sb_ = (unsigned)__builtin_amdgcn_readfirstlane(lds0 + (unsigned)(s_ & 3) * AT_SLOT + wofs); glds16s(kt_, koff, sb_); glds16s(vt_, voff, sb_ + (unsigned)AT_VOFF); } while (0)
        AT_ISSUE(0); AT_ISSUE(1); AT_ISSUE(2);
#pragma unroll 1
        for (int s = 0; s < n; ++s) {
            if (s + 2 < n) AT_WAIT_BAR(4); else if (s + 1 < n) AT_WAIT_BAR(2); else AT_WAIT_BAR(0);
            if (s + 3 < n) AT_ISSUE(s + 3);
            const LAS unsigned char* sk = F.lds + (s & 3) * AT_SLOT + bk; const LAS unsigned char* sv = F.lds + (s & 3) * AT_SLOT + bv;
#pragma unroll
            for (int hf = 0; hf < 2; ++hf) {
                const bf16x8 k00 = LDS_K(sk, hf * 32, 0, 0), k01 = LDS_K(sk, hf * 32, 0, 1), k10 = LDS_K(sk, hf * 32, 1, 0), k11 = LDS_K(sk, hf * 32, 1, 1);
                const bf16x8 v0 = LDS_V(sv, 0, hf * 4), v1 = LDS_V(sv, 1, hf * 4), v2 = LDS_V(sv, 2, hf * 4), v3 = LDS_V(sv, 3, hf * 4);
                attn_group4(o, mx, ls, q, k00, k01, k10, k11, v0, v1, v2, v3);
            }
        }
#undef AT_ISSUE
        AT_WAIT_BAR(0);
        { int ln_ = F.lane; asm volatile("" : "+v"(ln_));
          bf16_t* op = MIX + (size_t)(qbase + (ln_ & 15)) * DM + kvh * 256 + 4 * (ln_ >> 4);
#pragma unroll
          for (int h = 0; h < 4; ++h) attn_store(op + h * 64, o[h], ls[h]); }
    }
}

DI void attn_evenctx_lds(Frame& F, const float* gk  , const float* gq  ) {
    const bf16_t* P = WSP(bf16_t, WS_BIG); const bf16_t* VT = WSP(bf16_t, WS_VT); bf16_t* MIX = WSP(bf16_t, WS_H);
    const int l16 = F.lane & 15, g = F.lane >> 4;
    const size_t kp = LDP_E;
    const unsigned lds0 = (unsigned)(uintptr_t)F.lds;
    const int drow = F.wave * 8 + (F.lane & 7), dsw = (F.lane >> 3) * 8;
    const unsigned koff = (unsigned)(drow * (int)kp + dsw) * 2u, voff = (unsigned)(drow * TT + dsw) * 2u;
    const unsigned wofs = (unsigned)F.wave * AT_GRP;
    const float kn = 8.0f * 1.01f * wave_max(fabsf(gk[F.lane])) * (0.125f * LOG2E);
    const int bk = (l16 >> 3) * AT_GRP + (l16 & 7) * 16 + g * 128, bv = AT_VOFF + (l16 >> 3) * AT_GRP + (l16 & 7) * 16 + (g >> 1) * 128 + (g & 1) * 8;
    __syncthreads();
    for (int item = F.vcu; item < NB * 12; item += F.G) {
        const int b = item / 12, h = item % 12;
        const bool act = F.wave < 4;
        const int qbase = TL + b * CTXL + (F.wave & 3) * 64;
        const int nlat = 0;
        const int qrow = qbase + l16;
        const bf16_t* qp = P + (size_t)qrow * kp + h * 64 + g * 8;
        bf16x8 q[4][2]; f32x4 o[4][4]; float mx[4], ls[4];
#pragma unroll
        for (int h = 0; h < 4; ++h) { q[h][0] = *(const bf16x8*)(qp + (size_t)(16 * h) * kp); q[h][1] = *(const bf16x8*)(qp + (size_t)(16 * h) * kp + 32); { int gl_ = g; asm volatile("" : "+v"(gl_)); q_prep<false>(q[h][0], q[h][1], gq, gl_, nullptr, 0); } mx[h] = q_norm(q[h][0], q[h][1]) * kn; ls[h] = 0.f;
#pragma unroll
            for (int d = 0; d < 4; ++d) o[h][d] = (f32x4){0.f, 0.f, 0.f, 0.f}; }
        const bf16_t* Kl = nullptr; const bf16_t* Vl = nullptr;
        const bf16_t* Kc = P + (size_t)(TL + b * CTXL) * kp + 768 + h * 64; const bf16_t* Vc = VT + (size_t)(h * 64) * TT + TL + b * CTXL;
        const int n = nlat + 4;
#define AT_ISSUE(s) do { const int s_ = (s); const bf16_t* kt_ = s_ < nlat ? Kl + (size_t)s_ * 64 * kp : Kc + (size_t)(s_ - nlat) * 64 * kp; const bf16_t* vt_ = s_ < nlat ? Vl + s_ * 64 : Vc + (s_ - nlat) * 64; \
        const unsigned sb_ = (unsigned)__builtin_amdgcn_readfirstlane(lds0 + (unsigned)(s_ & 3) * AT_SLOT + wofs); glds16s(kt_, koff, sb_); glds16s(vt_, voff, sb_ + (unsigned)AT_VOFF); } while (0)
        AT_ISSUE(0); AT_ISSUE(1); AT_ISSUE(2);
#pragma unroll 1
        for (int s = 0; s < n; ++s) {
            if (s + 2 < n) AT_WAIT_BAR(4); else if (s + 1 < n) AT_WAIT_BAR(2); else AT_WAIT_BAR(0);
            if (s + 3 < n) AT_ISSUE(s + 3);
            const LAS unsigned char* sk = F.lds + (s & 3) * AT_SLOT + bk; const LAS unsigned char* sv = F.lds + (s & 3) * AT_SLOT + bv;
            if (act)
#pragma unroll
            for (int hf = 0; hf < 2; ++hf) {
                const bf16x8 k00 = LDS_K(sk, hf * 32, 0, 0), k01 = LDS_K(sk, hf * 32, 0, 1), k10 = LDS_K(sk, hf * 32, 1, 0), k11 = LDS_K(sk, hf * 32, 1, 1);
                const bf16x8 v0 = LDS_V(sv, 0, hf * 4), v1 = LDS_V(sv, 1, hf * 4), v2 = LDS_V(sv, 2, hf * 4), v3 = LDS_V(sv, 3, hf * 4);
                attn_group4(o, mx, ls, q, k00, k01, k10, k11, v0, v1, v2, v3);
            }
        }
#undef AT_ISSUE
        AT_WAIT_BAR(0);
        { int ln_ = F.lane; asm volatile("" : "+v"(ln_));
          bf16_t* op = MIX + (size_t)(qbase + (ln_ & 15)) * DM + h * 64 + 4 * (ln_ >> 4);
          if (act) {
#pragma unroll
          for (int i = 0; i < 4; ++i) attn_store(op + (size_t)(16 * i) * DM, o[i], ls[i]); } }
    }
}

DI void attn_even_lds(Frame& F, const float* rpb  , const float* gk  , const float* gq  ) {
    const bf16_t* P = WSP(bf16_t, WS_BIG); const bf16_t* VT = WSP(bf16_t, WS_VT); bf16_t* MIX = WSP(bf16_t, WS_H);
    const int l16 = F.lane & 15, g = F.lane >> 4;
    const size_t kp = LDP_E;
    const unsigned lds0 = (unsigned)(uintptr_t)F.lds;
    LAS float* blall = (LAS float*)(F.lds + 4 * AT_SLOT);
    const int drow = F.wave * 8 + (F.lane & 7), dsw = (F.lane >> 3) * 8;
    const unsigned koff = (unsigned)(drow * (int)kp + dsw) * 2u, voff = (unsigned)(drow * TT + dsw) * 2u;
    const unsigned wofs = (unsigned)F.wave * AT_GRP;
    const float kn = 8.0f * 1.01f * wave_max(fabsf(gk[F.lane])) * (0.125f * LOG2E);
    const int bk = (l16 >> 3) * AT_GRP + (l16 & 7) * 16 + g * 128, bv = AT_VOFF + (l16 >> 3) * AT_GRP + (l16 & 7) * 16 + (g >> 1) * 128 + (g & 1) * 8;
    LAS u32x4* dct = (LAS u32x4*)(F.lds + 4 * AT_SLOT + 22528);
    float bmx = 0.f;
    for (int i = F.tid; i < 12 * 465; i += 512) { const float bv_ = rpb[i] * LOG2E; blall[i] = bv_; bmx = fmaxf(bmx, fabsf(bv_)); }
    LAS float* wm = (LAS float*)(F.lds + 4 * AT_SLOT + 22528 + 4096);
    bmx = wave_max(bmx); if (F.lane == 0) wm[F.wave] = bmx;
    if (F.wave == 0) {
#pragma unroll
        for (int j = 0; j < 4; ++j) {
            const int qc = 16 * j + l16, kcol0 = j == 0 ? 0 : (j == 1 ? 8 : (j == 2 ? 24 : 32)), cs = qc < 8 ? 0 : (qc > 56 ? 48 : qc - 8);
            unsigned a = 0u, bb = 0u, vm = 0u;
#pragma unroll
            for (int e = 0; e < 8; ++e) { const int kc = kcol0 + (e < 4 ? 4 * g + e : 16 + 4 * g + (e - 4));
                if (kc >= cs && kc < cs + 16) vm |= 1u << e;
                int d = kc - qc + 15; d = d < 0 ? 0 : (d > 30 ? 30 : d);
                if (e < 4) a |= (unsigned)d << (8 * e); else bb |= (unsigned)d << (8 * (e - 4)); }
            dct[j * 64 + F.lane] = (u32x4){a, bb, vm, 0u};
        }
    }
    __syncthreads();
    const float bmax = fmaxf(fmaxf(fmaxf(wm[0], wm[1]), fmaxf(wm[2], wm[3])), fmaxf(fmaxf(wm[4], wm[5]), fmaxf(wm[6], wm[7])));
    for (int item = F.vcu; item < NB * 12 * 8; item += F.G) {
        const int b = item / 96, rem = item % 96, h = rem >> 3, rg = rem & 7, r = rg * 8 + F.wave;
        const int r0 = r < 4 ? 0 : (r > 60 ? 56 : r - 4);
        const int rlo = rg == 0 ? 0 : rg * 8 - 4, rhi = (rg == 7 ? 56 : rg * 8 + 3) + 7;
        const int nloc = rhi - rlo + 1, n = nloc + 4;
        const LAS float* bl = blall + h * 465;
        bf16x8 q[4][2]; f32x4 o[4][4]; float mx[4], ls[4];
        const int qrow0 = b * SEQ + r * 64 + l16;
#pragma unroll
        for (int j = 0; j < 4; ++j) { const bf16_t* qp = P + (size_t)(qrow0 + 16 * j) * kp + h * 64 + g * 8; q[j][0] = *(const bf16x8*)qp; q[j][1] = *(const bf16x8*)(qp + 32); { int gl_ = g; asm volatile("" : "+v"(gl_)); q_prep<false>(q[j][0], q[j][1], gq, gl_, nullptr, 0); } mx[j] = q_norm(q[j][0], q[j][1]) * kn + bmax; ls[j] = 0.f;
#pragma unroll
            for (int d = 0; d < 4; ++d) o[j][d] = (f32x4){0.f, 0.f, 0.f, 0.f}; }
        const bf16_t* Kl = P + (size_t)(b * SEQ + rlo * 64) * kp + 768 + h * 64; const bf16_t* Vl = VT + (size_t)(h * 64) * TT + b * SEQ + rlo * 64;
        const bf16_t* Kc = P + (size_t)(TL + b * CTXL) * kp + 768 + h * 64; const bf16_t* Vc = VT + (size_t)(h * 64) * TT + TL + b * CTXL;
#define AT_ISSUE(s) do { const int s_ = (s); const bf16_t* kt_ = s_ < nloc ? Kl + (size_t)s_ * 64 * kp : Kc + (size_t)(s_ - nloc) * 64 * kp; const bf16_t* vt_ = s_ < nloc ? Vl + s_ * 64 : Vc + (s_ - nloc) * 64; \
        const unsigned sb_ = (unsigned)__builtin_amdgcn_readfirstlane(lds0 + (unsigned)(s_ & 3) * AT_SLOT + wofs); glds16s(kt_, koff, sb_); glds16s(vt_, voff, sb_ + (unsigned)AT_VOFF); } while (0)
        AT_ISSUE(0); AT_ISSUE(1); AT_ISSUE(2);
#pragma unroll 1
        for (int s = 0; s < n; ++s) {
            if (s + 2 < n) AT_WAIT_BAR(4); else if (s + 1 < n) AT_WAIT_BAR(2); else AT_WAIT_BAR(0);
            if (s + 3 < n) AT_ISSUE(s + 3);
            const LAS unsigned char* sk = F.lds + (s & 3) * AT_SLOT + bk; const LAS unsigned char* sv = F.lds + (s & 3) * AT_SLOT + bv;
            if (s < nloc) {
                const int kr = rlo + s;
                if (kr >= r0 && kr < r0 + 8) {
                    const LAS float* rp = bl + (kr - r + 7) * 31;
#pragma unroll
                    for (int j = 0; j < 4; ++j) {
                        const int kc0 = j == 0 ? 0 : (j == 1 ? 8 : (j == 2 ? 24 : 32));
                        const bf16x8 k00 = LDS_K(sk, kc0, 0, 0), k01 = LDS_K(sk, kc0, 0, 1), k10 = LDS_K(sk, kc0, 1, 0), k11 = LDS_K(sk, kc0, 1, 1);
                        const bf16x8 v0 = LDS_V(sv, 0, kc0 >> 3), v1 = LDS_V(sv, 1, kc0 >> 3), v2 = LDS_V(sv, 2, kc0 >> 3), v3 = LDS_V(sv, 3, kc0 >> 3);
                        f32x4 b0, b1; const u32x4 dt_ = dct[j * 64 + F.lane]; unsigned da_ = dt_.x, db_ = dt_.y;
#pragma unroll
                        for (int e = 0; e < 4; ++e) { b0[e] = rp[(da_ >> (8 * e)) & 255u]; b1[e] = rp[(db_ >> (8 * e)) & 255u]; }
                        attn_head<true>(o[j], mx[j], ls[j], q[j][0], q[j][1], k00, k01, k10, k11, v0, v1, v2, v3, b0, b1, dt_.z);
                        __builtin_amdgcn_sched_barrier(0);
                    }
                }
            } else {
#pragma unroll
                for (int hf = 0; hf < 2; ++hf) {
                    const bf16x8 k00 = LDS_K(sk, hf * 32, 0, 0), k01 = LDS_K(sk, hf * 32, 0, 1), k10 = LDS_K(sk, hf * 32, 1, 0), k11 = LDS_K(sk, hf * 32, 1, 1);
                    const bf16x8 v0 = LDS_V(sv, 0, hf * 4), v1 = LDS_V(sv, 1, hf * 4), v2 = LDS_V(sv, 2, hf * 4), v3 = LDS_V(sv, 3, hf * 4);
                    attn_group4(o, mx, ls, q, k00, k01, k10, k11, v0, v1, v2, v3);
                    __builtin_amdgcn_sched_barrier(0);
                }
            }
        }
#undef AT_ISSUE
        AT_WAIT_BAR(0);
        { int ln_ = F.lane; asm volatile("" : "+v"(ln_));
          bf16_t* op = MIX + (size_t)(b * SEQ + r * 64 + (ln_ & 15)) * DM + h * 64 + 4 * (ln_ >> 4);
#pragma unroll
          for (int j = 0; j < 4; ++j) attn_store(op + (size_t)(16 * j) * DM, o[j], ls[j]); }
    }
}

DI void sgu_phase(Frame& F, const Args& AR, int io) {
    const bf16_t* P = WSP(bf16_t, WS_BIG); bf16_t* MIX = WSP(bf16_t, WS_H);
    const bf16_t* WSB = WSP(bf16_t, WS_WSB) + (size_t)io * 4 * 128 * 128;
    const float* vg = in_ptr(AR, 16) + io * 512; const float* bs = in_ptr(AR, 18) + io * 512;
    LAS bf16_t* VT = (LAS bf16_t*)F.lds;
    __syncthreads();
    const int l16 = F.lane & 15, g4 = F.lane >> 4;
    const int j = F.tid >> 2, qd = F.tid & 3;
    constexpr int NU = (TT / 128) * 4;
    bf16x8 raw[4];
    if (F.vcu < NU) { const bf16_t* src = P + (size_t)((F.vcu >> 2) * 128 + j) * LDP_O + 1280 + (F.vcu & 3) * 128 + qd * 32;
#pragma unroll
        for (int i = 0; i < 4; ++i) raw[i] = *(const bf16x8*)(src + 8 * i); }
    for (int unit = F.vcu; unit < NU; unit += F.G) {
        const int chunk = unit >> 2, grp = unit & 3, row0 = chunk * 128;
        {
            float v[32]; float ss = 0.f;
#pragma unroll
            for (int i = 0; i < 4; ++i) {
#pragma unroll
                for (int e = 0; e < 8; ++e) { const float x = gelu_f(bf2f(raw[i][e])); v[8 * i + e] = x; ss += x * x; } }
            ss += __shfl_xor(ss, 1); ss += __shfl_xor(ss, 2);
            const float rstd = rsqrtf(ss * (1.0f / 128.0f) + EPS);
#pragma unroll
            for (int e = 0; e < 32; ++e) { const int c = qd * 32 + e; VT[c * 136 + j] = (bf16_t)(pk2(v[e] * rstd * vg[grp * 128 + c], 0.f) & 0xffffu); }
        }
        __syncthreads();
        const int nu = unit + F.G;
        if (nu < NU) { const bf16_t* src = P + (size_t)((nu >> 2) * 128 + j) * LDP_O + 1280 + (nu & 3) * 128 + qd * 32;
#pragma unroll
            for (int i = 0; i < 4; ++i) raw[i] = *(const bf16x8*)(src + 8 * i); }
        f32x4 acc[8];
#pragma unroll
        for (int cb = 0; cb < 8; ++cb) acc[cb] = (f32x4){0.f, 0.f, 0.f, 0.f};
        const int ti = F.wave * 16 + l16;
        const bf16_t* wp = WSB + (size_t)grp * 128 * 128 + (size_t)ti * 128 + 8 * g4;
        const bf16_t* up = P + (size_t)(row0 + ti) * LDP_O + 768 + grp * 128 + 4 * g4;
        bf16x8 bw[4]; s16x4 ur[8];
#pragma unroll
        for (int ks = 0; ks < 4; ++ks) bw[ks] = *(const bf16x8*)(wp + 32 * ks);
#pragma unroll
        for (int cb = 0; cb < 8; ++cb) ur[cb] = *(const s16x4*)(up + 16 * cb);
        const float bias = bs[grp * 128 + ti];
#pragma unroll
        for (int ks = 0; ks < 4; ++ks) {
#pragma unroll
            for (int cb = 0; cb < 8; ++cb) { const bf16x8 av = *(const LAS bf16x8*)(VT + (16 * cb + l16) * 136 + 32 * ks + 8 * g4); acc[cb] = MFMA16(av, bw[ks], acc[cb]); }
        }
        bf16_t* op = MIX + (size_t)(row0 + ti) * DM + 512 + grp * 128 + 4 * g4;
#pragma unroll
        for (int cb = 0; cb < 8; ++cb) { u32x2 w;
            w.x = pk2(gelu_f(bf2f(ur[cb][0])) * (acc[cb][0] + bias), gelu_f(bf2f(ur[cb][1])) * (acc[cb][1] + bias));
            w.y = pk2(gelu_f(bf2f(ur[cb][2])) * (acc[cb][2] + bias), gelu_f(bf2f(ur[cb][3])) * (acc[cb][3] + bias));
            *(u32x2*)(op + 16 * cb) = w; }
        __syncthreads();
    }
}

#ifndef PM
#define PM 0xffff
#endif
#ifndef REP
#define REP 0
#endif
DI void grid_barrier(unsigned* cnt, unsigned target) {
    asm volatile("s_waitcnt vmcnt(0) lgkmcnt(0)" ::: "memory");
    __syncthreads();
    if (threadIdx.x == 0) {
        __builtin_amdgcn_fence(__ATOMIC_RELEASE, "agent");
        asm volatile("s_waitcnt vmcnt(0)" ::: "memory");
        __hip_atomic_fetch_add(cnt, 1u, __ATOMIC_RELAXED, __HIP_MEMORY_SCOPE_AGENT);
        while (__hip_atomic_load(cnt, __ATOMIC_RELAXED, __HIP_MEMORY_SCOPE_AGENT) < target) __builtin_amdgcn_s_sleep(2);
        __builtin_amdgcn_fence(__ATOMIC_ACQUIRE, "agent");
        asm volatile("s_waitcnt vmcnt(0)" ::: "memory");
    }
    __syncthreads();
}
#define GRID_SYNC() do { nbar += (unsigned)gridDim.x; grid_barrier(barw, nbar); } while (0)
__global__ void __launch_bounds__(512, 2) fwd_megakernel(Args args) {
    extern __shared__ __attribute__((aligned(16))) unsigned char lds_raw[];
    cg::grid_group grid = cg::this_grid();
    Frame F;
    F.lds = (LAS unsigned char*)lds_raw;
    F.tid = threadIdx.x; F.lane = F.tid & 63; F.wave = __builtin_amdgcn_readfirstlane(F.tid >> 6);
    F.G = gridDim.x; { const int bx = blockIdx.x; F.vcu = (F.G % 8 == 0) ? (bx % 8) * (F.G / 8) + bx / 8 : bx; }
    F.out = GLOBAL_PTR(float, args.out); F.ws = GLOBAL_PTR(unsigned char, args.ws);
    int bx = blockIdx.x;

    const Args& AR = args;
    unsigned* barw = GLOBAL_PTR(unsigned, args.ws); unsigned nbar = 0u;
    grid.sync();
    if (PM & 1) prologue_a(F, AR, 5, 6);
    GRID_SYNC();
    if (PM & 2) prologue_b(F, AR);
    GRID_SYNC();
#pragma unroll 1
    for (int k_ = 0; k_ < 2; ++k_) {
        if ((k_ == 0) == ((blockIdx.x & 1) != 0)) norm_phase(F, in_ptr(AR, 0), in_ptr(AR, 2), in_ptr(AR, 4), WSP(float, WS_MOD), 0);
        else prologue_a(F, AR, 0, 5);
    }
    GRID_SYNC();

    enum { T_NOP = 0, T_NORM, T_SWI, T_RES, T_STORE, T_FT, T_POST, T_SGU, T_ATTE, T_ATTO };
#pragma unroll 1
    for (int l = 0; l < 4; ++l) {
        const bool even = (l & 1) == 0; const int li = l >> 1;
#pragma unroll 1
        for (int op = 0; op < 14; ++op) {
            { int t_ = threadIdx.x; asm volatile("" : "+v"(t_)); F.tid = t_; F.lane = t_ & 63; F.wave = __builtin_amdgcn_readfirstlane(t_ >> 6);
              unsigned char* w_ = args.ws; asm volatile("" : "+s"(w_)); F.ws = GLOBAL_PTR(unsigned char, w_); float* o_ = args.out; asm volatile("" : "+s"(o_)); F.out = GLOBAL_PTR(float, o_);
              int g_ = gridDim.x, b_ = blockIdx.x; asm volatile("" : "+s"(g_), "+s"(b_)); F.G = g_; bx = b_; F.vcu = (g_ % 8 == 0) ? (b_ % 8) * (g_ / 8) + b_ / 8 : b_; }
            bf16_t* H = WSP(bf16_t, WS_H); bf16_t* BIG = WSP(bf16_t, WS_BIG); float* XC = WSP(float, WS_XC);
            const float* modl = WSP(float, WS_MOD) + (size_t)l * NBI * MODW;
            const int opq = ((op == 6 || op == 7) && (bx & 1)) ? 13 - op : op;
            int type = T_NOP;
            const bool skip0 = (l == 0 && op == 0);
            if (op == 0 || op == 3 || op == 11) type = skip0 ? T_NOP : T_NORM;
            else if (op == 1 || op == 12) type = T_SWI;
            else if (op == 2 || op == 10 || op == 13) type = T_RES;
            else if (op == 4) type = T_STORE;
            else if (op == 5) type = even ? T_FT : T_NOP;
            else if (opq == 6) type = T_POST;
            else if (opq == 7) type = even ? T_STORE : T_SGU;
            else if (op == 8) type = even ? T_STORE : T_NOP;
            else if (op == 9) type = even ? T_ATTE : T_ATTO;
            const bool first = (l == 0 && op <= 2);
            const int nMt = (l == 3 && op >= 10) ? TL / 256 : TT / 256;
            const float* srcL = first ? in_ptr(AR, 0) : F.out; const float* srcC = first ? in_ptr(AR, 2) : XC;
            if (type == T_NORM) {
                const int sub = op == 0 ? 0 : (op == 3 ? 1 : 2);
                if (even && op == 3) norm_pair_phase(F, srcL, srcC, in_ptr(AR, 4) + (size_t)(l * 3 + sub) * DM, modl, sub);
                else norm_phase(F, srcL, srcC, in_ptr(AR, 4) + (size_t)(l * 3 + sub) * DM, modl, sub);
            } else if (type == T_SWI) {
                const int fi = l * 2 + (op == 1 ? 0 : 1);
                pg8::Gemm g{H, WSP(bf16_t, WS_WGU) + (size_t)fi * 2 * DFF * DM, DM, DM, DM, 0, 0}; pg8::Order S; S.init(nMt, 2 * DFF / 256, 1, F.G, bx);
                pg8::EpiSwiGLU E{BIG};
#pragma unroll 1
                for (int rep_ = 0; rep_ < ((REP & 4) ? 2 : 1); ++rep_) pg8::gemm_phase(F.lds, F.tid, g, S, E);
            } else if (type == T_RES) {
                pg8::Gemm g; pg8::EpiResid E; E.srcL = srcL; E.srcC = srcC; E.dstL = F.out; E.dstC = XC;
                if (op == 10) { g = pg8::Gemm{H, WSP(bf16_t, WS_WOUT) + (size_t)l * DM * DM, DM, DM, DM, 0, 0}; E.gate = modl + 1 * 3072 + 2048; E.coef = 1.0f; }
                else { const int fi = l * 2 + (op == 2 ? 0 : 1), sub = op == 2 ? 0 : 2; g = pg8::Gemm{BIG, WSP(bf16_t, WS_WD) + (size_t)fi * DM * DFF, DFF, DFF, DFF, 0, 0}; E.gate = modl + sub * 3072 + 2048; E.coef = 0.5f; }
                pg8::Order S; S.init(nMt, DM / 256, 1, F.G, bx);
                if (PM & 16) pg8::gemm_phase(F.lds, F.tid, g, S, E);
            } else if (type == T_STORE) {
                pg8::Gemm g; pg8::EpiStore E; pg8::Order S;
                if (op == 4) {
                    const bf16_t* W = even ? WSP(bf16_t, WS_WINAB) + (size_t)li * 2816 * DM : WSP(bf16_t, WS_WINCD) + (size_t)li * 1792 * DM;
                    const int ldp = even ? LDP_E : LDP_O;
                    g = pg8::Gemm{H, W, DM, DM, DM, 0, 0}; S.init(TT / 256, ldp / 256, 1, F.G, bx); E = pg8::EpiStore{BIG, ldp, 0, 1.0f};
                } else if (opq == 7) {
                    g = pg8::Gemm{WSP(bf16_t, WS_DFT), WSP(bf16_t, WS_FT), 4096, 4096, 4096, 0, (size_t)256 * 4096}; S.init(SEQ / 256, 1, NB, F.G, bx);
                    E = pg8::EpiStore{H + 768, DM, (size_t)SEQ * DM, 1.0f / 512.0f};
                } else {
                    g = pg8::Gemm{WSP(bf16_t, WS_DFTC), WSP(bf16_t, WS_FTC), 512, 512, 512, 0, (size_t)256 * 512}; S.init(1, 1, NB, F.G, bx);
                    E = pg8::EpiStore{H + (size_t)TL * DM + 768, DM, (size_t)CTXL * DM, 1.0f / 128.0f};
                }
                if (PM & 32) pg8::gemm_phase(F.lds, F.tid, g, S, E);
            } else if (type == T_FT) {
                pg8::EpiFT E{WSP(bf16_t, WS_FT), WSP(bf16_t, WS_FTC), WSP(bf16_t, WS_VT)};
#pragma unroll 1
                for (int part = 0; part < 2; ++part) {
                    pg8::Gemm g{WSP(bf16_t, WS_WINAB) + (size_t)li * 2816 * DM + (size_t)1536 * DM, part ? WSP(bf16_t, WS_HS) : H, DM, DM, DM, 0, 0};
                    pg8::Order S; if (part) S.init_fourier(F.G, bx); else S.init(3, TT / 256, 1, F.G, bx, 0);
                    if (PM & 64) pg8::gemm_phase(F.lds, F.tid, g, S, E);
                }
            } else if (type == T_POST) {
                if (PM & 128) postpass(F, even, even ? in_ptr(AR, 11) + li * 128 : in_ptr(AR, 15) + li * 128);
            } else if (type == T_SGU) {
                if (PM & 512) sgu_phase(F, AR, li);
            } else if (type == T_ATTE) {
                if (PM & 1024) { const float* qg_ = in_ptr(AR, 11) + li * 128; attn_even_lds(F, in_ptr(AR, 12) + (size_t)li * 12 * 465, qg_ + 64, qg_); attn_evenctx_lds(F, qg_ + 64, qg_); }
            } else if (type == T_ATTO) {
                if (PM & 2048) { const float* qg_ = in_ptr(AR, 15) + li * 128; attn_odd_lds(F, qg_ + 64, qg_, l < 3); }
            }
            if (!(op == 4 || op == 6 || op == 7 || skip0)) GRID_SYNC();
        }
    }
}

extern "C" void kernel_launch(void* const* d_in, const int* in_sizes, int n_in, void* d_out, int out_size, void* d_ws, size_t ws_size, hipStream_t stream) {
    static int grid = 0;
    if (grid == 0) {
        if (n_in != 19 || out_size != TL * DM || ws_size < WS_END) { fprintf(stderr, "kernel_launch: unexpected shapes (n_in %d out %d ws %zu)\n", n_in, out_size, ws_size); grid = -1; return; }
        int dev = 0, cus = 0, per_cu = 0;
        hipGetDevice(&dev); hipDeviceGetAttribute(&cus, hipDeviceAttributeMultiprocessorCount, dev);
        hipFuncSetAttribute((const void*)fwd_megakernel, hipFuncAttributeMaxDynamicSharedMemorySize, LDS_BYTES);
        hipOccupancyMaxActiveBlocksPerMultiprocessor(&per_cu, (const void*)fwd_megakernel, 512, LDS_BYTES);
        if (per_cu < 1) { fprintf(stderr, "kernel_launch: occupancy query says %d blocks/CU\n", per_cu); per_cu = 1; }
        grid = cus * per_cu;
        (void)hipGetLastError();
    }
    if (grid < 0) return;
    (void)hipMemsetAsync(d_ws, 0, 256, stream);
    Args a{};
    for (int i = 0; i < 19; ++i) a.in[i] = (const float*)d_in[i];
    a.out = (float*)d_out; a.ws = (unsigned char*)d_ws;
    void* kargs[] = {&a};
    hipError_t e = hipLaunchCooperativeKernel((const void*)fwd_megakernel, dim3(grid), dim3(512), kargs, LDS_BYTES, stream);
    if (e != hipSuccess) fprintf(stderr, "cooperative launch failed: %s (grid %d)\n", hipGetErrorString(e), grid);
}
```
